# Optimizing an MI355X kernel written in HIP

```python
import math
import jax, jax.numpy as jnp
from jax import lax
import numpy as np

D_MODEL = 1024
BATCH = 8
SEQ = 2048
DEPTH = 2
DEC_BATCH = 128
DEC_SEQ = 8
PAST_LEN = 16384
PAGE_SIZE = 128

GLA_HEADS = 4
GLA_DK = D_MODEL // 8
GLA_DV = D_MODEL // 4
GLA_GATE_RANK = 16
GLA_GATE_NORM = 16.0
GLA_CHUNK = 64
RWKV_HEAD = 64
RWKV_HEADS = D_MODEL // RWKV_HEAD
RWKV_WIDTH = RWKV_HEADS * RWKV_HEAD
RWKV_DECAY_LORA = 64
RWKV_A_LORA = 64
RWKV_G_LORA = 128
RWKV_GN_EPS = 64e-5
LRU_WIDTH = D_MODEL
LRU_BLOCKS = 8
LRU_BLOCK = LRU_WIDTH // LRU_BLOCKS
LRU_C = 8.0
CONV_W = 4
SSD_INNER = D_MODEL
SSD_HEADDIM = 64
SSD_HEADS = SSD_INNER // SSD_HEADDIM
SSD_GROUPS = 2
SSD_STATE = 128
SSD_CHUNK = 64
SSD_CONV_CH = SSD_INNER + 2 * SSD_GROUPS * SSD_STATE
D_FF = -(-8 * D_MODEL // (3 * 256)) * 256
NORM_EPS = 1e-6
GLA_COLS = 2 * GLA_HEADS * GLA_DK + 2 * GLA_HEADS * GLA_DV + GLA_GATE_RANK
RWKV_COLS = 3 * RWKV_WIDTH + RWKV_DECAY_LORA + RWKV_A_LORA + RWKV_G_LORA
IN0 = GLA_COLS + RWKV_COLS
MIX0 = GLA_HEADS * GLA_DV + RWKV_WIDTH
IN1 = 2 * LRU_WIDTH + SSD_INNER + SSD_CONV_CH + SSD_HEADS
MIX1 = LRU_WIDTH + SSD_INNER

kernel_name = 'hybrid_gla_rwkv7_rglru_ssd_decode_step'


def rmsnorm(x, g, eps=NORM_EPS):
    xf = x.astype(jnp.float32)
    y = xf * lax.rsqrt(jnp.mean(xf * xf, axis=-1, keepdims=True) + eps)
    return (y * g.astype(jnp.float32)).astype(x.dtype)


def split_cols(t, sizes):
    idx = np.cumsum(sizes)[:-1].tolist()
    return jnp.split(t, idx, axis=-1)


def pad_time(t, total):
    pad = total - t.shape[1]
    return jnp.pad(t, [(0, 0), (0, pad)] + [(0, 0)] * (t.ndim - 2))


def causal_dwconv(u, buf, w, b):
    t_len = u.shape[1]
    full = jnp.concatenate([buf.astype(u.dtype), u], axis=1)
    y = b
    for j in range(CONV_W):
        y = y + full[:, j:j + t_len] * w[j]
    return y, full[:, -(CONV_W - 1):]


def gla_chunked(q, k, v, log_a, s0):
    f32 = jnp.float32
    bsz, t_len, nh, _ = q.shape
    dv = v.shape[-1]
    c = min(GLA_CHUNK, t_len)
    n = -(-t_len // c)
    q, k, v, log_a = [pad_time(t.astype(f32), n * c).reshape(bsz, n, c, nh, t.shape[-1]) for t in (q, k, v, log_a)]
    b = jnp.cumsum(log_a, axis=2)
    b_last = b[:, :, -1]
    qd = q * jnp.exp(b)
    kd = k * jnp.exp(-b)
    mask = jnp.tril(jnp.ones((c, c), bool))
    scores = jnp.where(mask, jnp.einsum('bnihd,bnjhd->bnhij', qd, kd), 0.0)
    o_intra = jnp.einsum('bnhij,bnjhv->bnihv', scores, v)
    kc = k * jnp.exp(b_last[:, :, None] - b)
    d_state = jnp.einsum('bnjhd,bnjhv->bnhdv', kc, v)
    decay = jnp.exp(b_last)

    def step(s, inp):
        dec, ds = inp
        return s * dec[..., None] + ds, s

    s_fin, s_in = lax.scan(step, s0.astype(f32), (jnp.moveaxis(decay, 1, 0), jnp.moveaxis(d_state, 1, 0)))
    s_in = jnp.moveaxis(s_in, 0, 1)
    o = o_intra + jnp.einsum('bnihd,bnhdv->bnihv', qd, s_in)
    return o.reshape(bsz, n * c, nh, dv)[:, :t_len], s_fin


def rwkv7_scan(r, w, k, v, kk, a, s0):
    def step(s, inp):
        r_t, w_t, k_t, v_t, kk_t, a_t = inp
        sa = jnp.einsum('bhij,bhj->bhi', s, -kk_t)
        s = s * w_t[:, :, None, :] + sa[..., None] * (kk_t * a_t)[:, :, None, :] + v_t[..., None] * k_t[:, :, None, :]
        return s, jnp.einsum('bhij,bhj->bhi', s, r_t)

    xs = tuple(jnp.moveaxis(t, 1, 0) for t in (r, w, k, v, kk, a))
    s_fin, y = lax.scan(step, s0.astype(jnp.float32), xs)
    return jnp.moveaxis(y, 0, 1), s_fin


def ssd_chunked(x, dt, A, bm, cm, s0):
    f32 = jnp.float32
    bsz, t_len, nh, hp = x.shape
    ng, ns = bm.shape[2], bm.shape[3]
    hg = nh // ng
    c = min(SSD_CHUNK, t_len)
    n = -(-t_len // c)
    tot = n * c
    x = pad_time(x.astype(f32), tot).reshape(bsz, n, c, ng, hg, hp)
    dt = pad_time(dt.astype(f32), tot).reshape(bsz, n, c, ng, hg)
    bm = pad_time(bm.astype(f32), tot).reshape(bsz, n, c, ng, ns)
    cm = pad_time(cm.astype(f32), tot).reshape(bsz, n, c, ng, ns)
    cs = jnp.cumsum(dt * A.astype(f32).reshape(ng, hg), axis=2)
    seg = cs[:, :, :, None] - cs[:, :, None, :]
    mask = jnp.tril(jnp.ones((c, c), bool))[:, :, None, None]
    lmat = jnp.exp(jnp.where(mask, seg, -jnp.inf))
    xdt = x * dt[..., None]
    cb = jnp.einsum('bnigs,bnjgs->bngij', cm, bm)
    y_intra = jnp.einsum('bngij,bnijgh,bnjghp->bnighp', cb, lmat, xdt)
    cs_last = cs[:, :, -1]
    wts = jnp.exp(cs_last[:, :, None] - cs)
    d_state = jnp.einsum('bnjgs,bnjgh,bnjghp->bnghps', bm, wts, xdt)
    decay = jnp.exp(cs_last)

    def step(s, inp):
        dec, ds = inp
        return s * dec[..., None, None] + ds, s

    s_init = s0.astype(f32).reshape(bsz, ng, hg, hp, ns)
    s_fin, s_in = lax.scan(step, s_init, (jnp.moveaxis(decay, 1, 0), jnp.moveaxis(d_state, 1, 0)))
    s_in = jnp.moveaxis(s_in, 0, 1)
    y_inter = jnp.einsum('bnigs,bnigh,bnghps->bnighp', cm, jnp.exp(cs), s_in)
    y = (y_intra + y_inter).reshape(bsz, tot, nh, hp)[:, :t_len]
    return y, s_fin.reshape(bsz, nh, hp, ns)


def mix_ab(h, s_gla, s_rwkv, s_shift, w_in0, gla_w_a2, gla_b_a, gla_g_norm, rwkv_mu, rwkv_w0, rwkv_w2,
           rwkv_a0, rwkv_a2, rwkv_g2, rwkv_k_k, rwkv_k_a, rwkv_r_k, rwkv_ln_w, rwkv_ln_b, w_out0):
    f32 = jnp.float32
    bsz, t_len, _ = h.shape
    proj = h @ w_in0
    gla_cols, rwkv_cols = proj[..., :GLA_COLS], proj[..., GLA_COLS:]
    q, k, v, a_low, og = split_cols(gla_cols, [GLA_HEADS * GLA_DK, GLA_HEADS * GLA_DK, GLA_HEADS * GLA_DV,
                                              GLA_GATE_RANK, GLA_HEADS * GLA_DV])
    q = q.reshape(bsz, t_len, GLA_HEADS, GLA_DK) * (GLA_DK ** -0.5)
    k = k.reshape(bsz, t_len, GLA_HEADS, GLA_DK)
    v = v.reshape(bsz, t_len, GLA_HEADS, GLA_DV)
    log_a = jax.nn.log_sigmoid((a_low @ gla_w_a2 + gla_b_a).astype(f32)) / GLA_GATE_NORM
    log_a = log_a.reshape(bsz, t_len, GLA_HEADS, GLA_DK)
    o, s_gla_new = gla_chunked(q, k, v, log_a, s_gla)
    o = rmsnorm(o, gla_g_norm, 1e-5).reshape(bsz, t_len, GLA_HEADS * GLA_DV)
    o_gla = o * jax.nn.silu(og.astype(f32))
    prev = jnp.concatenate([s_shift[:, None].astype(rwkv_cols.dtype), rwkv_cols[:, :-1]], axis=1)
    mixed = rwkv_cols + (prev - rwkv_cols) * rwkv_mu
    r, kr, vr, w_low, a_lr, g_low = [t.astype(f32) for t in split_cols(
        mixed, [RWKV_WIDTH, RWKV_WIDTH, RWKV_WIDTH, RWKV_DECAY_LORA, RWKV_A_LORA, RWKV_G_LORA])]
    w = -jax.nn.softplus(-(rwkv_w0 + jnp.tanh(w_low) @ rwkv_w2)) - 0.5
    decay = jnp.exp(-jnp.exp(w))
    a = jax.nn.sigmoid(rwkv_a0 + a_lr @ rwkv_a2)
    g = jax.nn.sigmoid(g_low) @ rwkv_g2
    hd = lambda t: t.reshape(bsz, t_len, RWKV_HEADS, RWKV_HEAD)
    kk = hd(kr * rwkv_k_k)
    kk = kk / jnp.maximum(jnp.sqrt(jnp.sum(kk * kk, axis=-1, keepdims=True)), 1e-12)
    kr = kr * (1.0 + (a - 1.0) * rwkv_k_a)
    r_h, k_h, v_h = hd(r), hd(kr), hd(vr)
    y, s_rwkv_new = rwkv7_scan(r_h, hd(decay), k_h, v_h, kk, hd(a), s_rwkv)
    mu = jnp.mean(y, axis=-1, keepdims=True)
    var = jnp.mean(jnp.square(y - mu), axis=-1, keepdims=True)
    y = ((y - mu) * lax.rsqrt(var + RWKV_GN_EPS)).reshape(bsz, t_len, RWKV_WIDTH) * rwkv_ln_w + rwkv_ln_b
    bonus = jnp.sum(r_h * k_h * rwkv_r_k, axis=-1, keepdims=True) * v_h
    y_rwkv = (y + bonus.reshape(bsz, t_len, RWKV_WIDTH)) * g
    out = jnp.concatenate([o_gla, y_rwkv], axis=-1).astype(h.dtype) @ w_out0
    return out, s_gla_new, s_rwkv_new, rwkv_cols[:, -1]


def mix_cd(h, s_lru, s_lru_conv, s_ssd, s_ssd_conv, w_in1, lru_conv_w, lru_conv_b, lru_w_r, lru_b_r, lru_w_i,
           lru_b_i, lru_lambda, ssd_conv_w, ssd_conv_b, ssd_dt_bias, ssd_a_log, ssd_d, ssd_norm_w, w_out1):
    f32 = jnp.float32
    bsz, t_len, _ = h.shape
    proj = h @ w_in1
    gate_br, x_br, z, xbc, dt = split_cols(proj, [LRU_WIDTH, LRU_WIDTH, SSD_INNER, SSD_CONV_CH, SSD_HEADS])
    xc, lru_conv_new = causal_dwconv(x_br, s_lru_conv, lru_conv_w, lru_conv_b)
    xb = xc.astype(f32).reshape(bsz, t_len, LRU_BLOCKS, LRU_BLOCK)
    rg = jax.nn.sigmoid(jnp.einsum('btnd,nde->btne', xb, lru_w_r) + lru_b_r)
    ig = jax.nn.sigmoid(jnp.einsum('btnd,nde->btne', xb, lru_w_i) + lru_b_i)
    log_a = -LRU_C * rg * jax.nn.softplus(-lru_lambda.astype(f32).reshape(LRU_BLOCKS, LRU_BLOCK))
    a = jnp.exp(log_a).reshape(bsz, t_len, LRU_WIDTH)
    bterm = (jnp.sqrt(-jnp.expm1(2.0 * log_a)) * ig * xb).reshape(bsz, t_len, LRU_WIDTH)
    bterm = bterm.at[:, 0].add(a[:, 0] * s_lru.astype(f32))
    comb = lambda l, r: (l[0] * r[0], r[0] * l[1] + r[1])
    _, hseq = lax.associative_scan(comb, (a, bterm), axis=1)
    lru_out = hseq * jax.nn.gelu(gate_br.astype(f32))
    xbc_c, ssd_conv_new = causal_dwconv(xbc, s_ssd_conv, ssd_conv_w, ssd_conv_b)
    xbc_c = jax.nn.silu(xbc_c.astype(f32))
    xs, bm, cm = split_cols(xbc_c, [SSD_INNER, SSD_GROUPS * SSD_STATE, SSD_GROUPS * SSD_STATE])
    xs = xs.reshape(bsz, t_len, SSD_HEADS, SSD_HEADDIM)
    bm = bm.reshape(bsz, t_len, SSD_GROUPS, SSD_STATE)
    cm = cm.reshape(bsz, t_len, SSD_GROUPS, SSD_STATE)
    dt = jax.nn.softplus(dt.astype(f32) + ssd_dt_bias)
    A = -jnp.exp(ssd_a_log.astype(f32))
    y, s_ssd_new = ssd_chunked(xs, dt, A, bm, cm, s_ssd)
    y = (y + ssd_d[:, None] * xs).reshape(bsz, t_len, SSD_INNER) * jax.nn.silu(z.astype(f32))
    yg = y.reshape(bsz, t_len, SSD_GROUPS, SSD_INNER // SSD_GROUPS)
    yg = yg * lax.rsqrt(jnp.mean(yg * yg, axis=-1, keepdims=True) + 1e-5)
    y_ssd = yg.reshape(bsz, t_len, SSD_INNER) * ssd_norm_w
    out = jnp.concatenate([lru_out, y_ssd], axis=-1).astype(h.dtype) @ w_out1
    return out, hseq[:, -1], lru_conv_new, s_ssd_new, ssd_conv_new


def swiglu(h, w_gate, w_up, w_down):
    return (jax.nn.silu(h @ w_gate) * (h @ w_up)) @ w_down


def trunk(x, states, ab_w, cd_w, ffn_w):
    s_gla, s_rwkv, s_shift, s_lru, s_lru_conv, s_ssd, s_ssd_conv = states
    g_mix, g_ffn, w_gate, w_up, w_down, g_final = ffn_w
    for layer in range(DEPTH):
        h = rmsnorm(x, g_mix[layer])
        if layer % 2 == 0:
            m, s_gla, s_rwkv, s_shift = mix_ab(h, s_gla, s_rwkv, s_shift, *ab_w)
        else:
            m, s_lru, s_lru_conv, s_ssd, s_ssd_conv = mix_cd(h, s_lru, s_lru_conv, s_ssd, s_ssd_conv, *cd_w)
        x = x + m.astype(x.dtype)
        x = x + swiglu(rmsnorm(x, g_ffn[layer]), w_gate[layer], w_up[layer], w_down[layer]).astype(x.dtype)
    return rmsnorm(x, g_final), (s_gla, s_rwkv, s_shift, s_lru, s_lru_conv, s_ssd, s_ssd_conv)


def setup_inputs(seed: int = 0) -> dict:
    key = jax.random.key(seed)
    ks = iter(jax.random.split(key, 64))
    f32 = jnp.float32
    nrm = lambda shape, scale: scale * jax.random.normal(next(ks), shape, f32)
    uni = lambda shape, lo, hi: jax.random.uniform(next(ks), shape, f32, lo, hi)
    dt0 = jnp.exp(uni((SSD_HEADS,), math.log(1e-3), math.log(1e-1)))
    return {
        'x_prompt': nrm((BATCH, SEQ, D_MODEL), 1.0),
        'x_sample': nrm((DEC_BATCH, DEC_SEQ, D_MODEL), 1.0),
        'state_gla': nrm((DEC_BATCH, GLA_HEADS, GLA_DK, GLA_DV), 0.5),
        'state_rwkv': nrm((DEC_BATCH, RWKV_HEADS, RWKV_HEAD, RWKV_HEAD), 0.3),
        'state_rwkv_shift': nrm((DEC_BATCH, RWKV_COLS), 1.0),
        'state_lru': nrm((DEC_BATCH, LRU_WIDTH), 0.5),
        'state_lru_conv': nrm((DEC_BATCH, CONV_W - 1, LRU_WIDTH), 1.0),
        'state_ssd': nrm((DEC_BATCH, SSD_HEADS, SSD_HEADDIM, SSD_STATE), 0.3),
        'state_ssd_conv': nrm((DEC_BATCH, CONV_W - 1, SSD_CONV_CH), 1.0),
        'w_in0': nrm((D_MODEL, IN0), D_MODEL ** -0.5),
        'gla_w_a2': nrm((GLA_GATE_RANK, GLA_HEADS * GLA_DK), GLA_GATE_RANK ** -0.5),
        'gla_b_a': 1.0 + nrm((GLA_HEADS * GLA_DK,), 0.5),
        'gla_g_norm': 1.0 + nrm((GLA_DV,), 0.1),
        'rwkv_mu': uni((RWKV_COLS,), 0.0, 1.0),
        'rwkv_w0': nrm((RWKV_WIDTH,), 0.5) - 0.5,
        'rwkv_w2': nrm((RWKV_DECAY_LORA, RWKV_WIDTH), 0.1 * RWKV_DECAY_LORA ** -0.5),
        'rwkv_a0': nrm((RWKV_WIDTH,), 0.5),
        'rwkv_a2': nrm((RWKV_A_LORA, RWKV_WIDTH), 0.5 * RWKV_A_LORA ** -0.5),
        'rwkv_g2': nrm((RWKV_G_LORA, RWKV_WIDTH), RWKV_G_LORA ** -0.5),
        'rwkv_k_k': 1.0 + nrm((RWKV_WIDTH,), 0.1),
        'rwkv_k_a': 1.0 + nrm((RWKV_WIDTH,), 0.1),
        'rwkv_r_k': nrm((RWKV_HEADS, RWKV_HEAD), 0.1),
        'rwkv_ln_w': 1.0 + nrm((RWKV_WIDTH,), 0.1),
        'rwkv_ln_b': nrm((RWKV_WIDTH,), 0.01),
        'w_out0': nrm((MIX0, D_MODEL), MIX0 ** -0.5),
        'w_in1': nrm((D_MODEL, IN1), D_MODEL ** -0.5),
        'lru_conv_w': nrm((CONV_W, LRU_WIDTH), CONV_W ** -0.5),
        'lru_conv_b': nrm((LRU_WIDTH,), 0.01),
        'lru_w_r': nrm((LRU_BLOCKS, LRU_BLOCK, LRU_BLOCK), LRU_BLOCK ** -0.5),
        'lru_b_r': nrm((LRU_BLOCKS, LRU_BLOCK), 0.01),
        'lru_w_i': nrm((LRU_BLOCKS, LRU_BLOCK, LRU_BLOCK), LRU_BLOCK ** -0.5),
        'lru_b_i': nrm((LRU_BLOCKS, LRU_BLOCK), 0.01),
        'lru_lambda': uni((LRU_WIDTH,), 4.3, 9.0),
        'ssd_conv_w': nrm((CONV_W, SSD_CONV_CH), CONV_W ** -0.5),
        'ssd_conv_b': nrm((SSD_CONV_CH,), 0.01),
        'ssd_dt_bias': dt0 + jnp.log(-jnp.expm1(-dt0)),
        'ssd_a_log': jnp.log(uni((SSD_HEADS,), 1.0, 16.0)),
        'ssd_d': 1.0 + nrm((SSD_HEADS,), 0.1),
        'ssd_norm_w': 1.0 + nrm((SSD_INNER,), 0.1),
        'w_out1': nrm((MIX1, D_MODEL), MIX1 ** -0.5),
        'g_mix': 1.0 + nrm((DEPTH, D_MODEL), 0.1),
        'g_ffn': 1.0 + nrm((DEPTH, D_MODEL), 0.1),
        'w_ffn_gate': nrm((DEPTH, D_MODEL, D_FF), D_MODEL ** -0.5),
        'w_ffn_up': nrm((DEPTH, D_MODEL, D_FF), D_MODEL ** -0.5),
        'w_ffn_down': nrm((DEPTH, D_FF, D_MODEL), D_FF ** -0.5),
        'g_final': 1.0 + nrm((D_MODEL,), 0.1),
    }


def reference(x_prompt, x_sample, state_gla, state_rwkv, state_rwkv_shift, state_lru, state_lru_conv, state_ssd,
              state_ssd_conv, w_in0, gla_w_a2, gla_b_a, gla_g_norm, rwkv_mu, rwkv_w0, rwkv_w2, rwkv_a0, rwkv_a2,
              rwkv_g2, rwkv_k_k, rwkv_k_a, rwkv_r_k, rwkv_ln_w, rwkv_ln_b, w_out0, w_in1, lru_conv_w, lru_conv_b,
              lru_w_r, lru_b_r, lru_w_i, lru_b_i, lru_lambda, ssd_conv_w, ssd_conv_b, ssd_dt_bias, ssd_a_log, ssd_d,
              ssd_norm_w, w_out1, g_mix, g_ffn, w_ffn_gate, w_ffn_up, w_ffn_down, g_final):
    f32 = jnp.float32
    ab_w = (w_in0, gla_w_a2, gla_b_a, gla_g_norm, rwkv_mu, rwkv_w0, rwkv_w2, rwkv_a0, rwkv_a2, rwkv_g2,
            rwkv_k_k, rwkv_k_a, rwkv_r_k, rwkv_ln_w, rwkv_ln_b, w_out0)
    cd_w = (w_in1, lru_conv_w, lru_conv_b, lru_w_r, lru_b_r, lru_w_i, lru_b_i, lru_lambda, ssd_conv_w,
            ssd_conv_b, ssd_dt_bias, ssd_a_log, ssd_d, ssd_norm_w, w_out1)
    ffn_w = (g_mix, g_ffn, w_ffn_gate, w_ffn_up, w_ffn_down, g_final)
    bp = x_prompt.shape[0]
    prompt_init = (
        jnp.zeros((bp, GLA_HEADS, GLA_DK, GLA_DV), f32),
        jnp.zeros((bp, RWKV_HEADS, RWKV_HEAD, RWKV_HEAD), f32),
        jnp.zeros((bp, RWKV_COLS), x_prompt.dtype),
        jnp.zeros((bp, LRU_WIDTH), f32),
        jnp.zeros((bp, CONV_W - 1, LRU_WIDTH), x_prompt.dtype),
        jnp.zeros((bp, SSD_HEADS, SSD_HEADDIM, SSD_STATE), f32),
        jnp.zeros((bp, CONV_W - 1, SSD_CONV_CH), x_prompt.dtype),
    )
    sample_init = (state_gla, state_rwkv, state_rwkv_shift, state_lru, state_lru_conv, state_ssd, state_ssd_conv)
    y_prompt, p_states = trunk(x_prompt, prompt_init, ab_w, cd_w, ffn_w)
    y_sample, s_states = trunk(x_sample, sample_init, ab_w, cd_w, ffn_w)
    p_gla, p_rwkv, p_shift, p_lru, p_lru_conv, p_ssd, p_ssd_conv = p_states
    s_gla, s_rwkv, s_shift, s_lru, s_lru_conv, s_ssd, s_ssd_conv = s_states
    return (y_prompt, y_sample, p_gla, p_rwkv, p_shift, p_lru, p_lru_conv, p_ssd, p_ssd_conv,
            s_gla, s_rwkv, s_shift, s_lru, s_lru_conv, s_ssd, s_ssd_conv)
```

```cpp
#include <hip/hip_runtime.h>
#include <hip/hip_cooperative_groups.h>
#include <cstdio>
namespace cg = cooperative_groups;

typedef unsigned short bf16_t;
typedef short bf16x8 __attribute__((ext_vector_type(8)));
typedef float f32x4 __attribute__((ext_vector_type(4)));

constexpr int DM = 1024;
constexpr int RP = 16384;
constexpr int MROWS = 17408;
constexpr int NSEQ = 136;
constexpr int LD0 = 6416, LD1 = 4624, DFF = 2816;
constexpr int C_Q = 0, C_K = 512, C_V = 1024, C_AL = 2048, C_OG = 2064;
constexpr int RW0 = 3088;
constexpr int C_R = RW0, C_KR = RW0 + 1024, C_VR = RW0 + 2048, C_LORA = RW0 + 3072;
constexpr int D_GATE = 0, D_XBR = 1024, D_Z = 2048, D_XBC = 3072, D_DT = 4608;

constexpr size_t O_Y = 0;
constexpr size_t O_PGLA = (size_t)MROWS * 1024;
constexpr size_t O_PRWKV = O_PGLA + 8ull * 4 * 128 * 256;
constexpr size_t O_PSHIFT = O_PRWKV + 8ull * 16 * 64 * 64;
constexpr size_t O_PLRU = O_PSHIFT + 8ull * 3328;
constexpr size_t O_PLRUC = O_PLRU + 8ull * 1024;
constexpr size_t O_PSSD = O_PLRUC + 8ull * 3 * 1024;
constexpr size_t O_PSSDC = O_PSSD + 8ull * 16 * 64 * 128;
constexpr size_t O_SGLA = O_PSSDC + 8ull * 3 * 1536;
constexpr size_t O_SRWKV = O_SGLA + 128ull * 4 * 128 * 256;
constexpr size_t O_SSHIFT = O_SRWKV + 128ull * 16 * 64 * 64;
constexpr size_t O_SLRU = O_SSHIFT + 128ull * 3328;
constexpr size_t O_SLRUC = O_SLRU + 128ull * 1024;
constexpr size_t O_SSSD = O_SLRUC + 128ull * 3 * 1024;
constexpr size_t O_SSSDC = O_SSSD + 128ull * 16 * 64 * 128;
constexpr size_t O_END = O_SSSDC + 128ull * 3 * 1536;

enum {
  I_XP = 0, I_XS, I_SGLA, I_SRWKV, I_SSHIFT, I_SLRU, I_SLRUC, I_SSSD, I_SSSDC,
  I_WIN0, I_GLA_WA2, I_GLA_BA, I_GLA_GN, I_MU, I_W0, I_W2, I_A0, I_A2, I_G2, I_KK, I_KA, I_RK, I_LNW, I_LNB, I_WOUT0,
  I_WIN1, I_LCW, I_LCB, I_LWR, I_LBR, I_LWI, I_LBI, I_LAMBDA, I_SCW, I_SCB, I_DTB, I_ALOG, I_SD, I_SNW, I_WOUT1,
  I_GMIX, I_GFFN, I_WG, I_WU, I_WD, I_GFINAL, N_IN
};

struct Params {
  const float* in[N_IN];
  float* out;
  bf16_t *Win0t, *Wout0t, *Win1t, *Wout1t, *Wgu0, *Wgu1, *Wdn0, *Wdn1, *w2t, *a2t, *g2t, *Wri;
  bf16_t *H, *PROJ, *L, *LA, *GG, *EW, *AA, *XC, *XBC, *GX;
  float* DT;
  unsigned* ctr;
  unsigned* bar;
  int ph_begin, ph_end;
  int rep_long, rep_short;
};

typedef const Params __attribute__((address_space(4)))* KP;

__device__ __forceinline__ float bf2f(bf16_t v) { return __uint_as_float(((unsigned)v) << 16); }
__device__ __forceinline__ bf16_t f2bf(float f) {
  unsigned u = __float_as_uint(f);
  u += 0x7fffu + ((u >> 16) & 1u);
  return (bf16_t)(u >> 16);
}
__device__ __forceinline__ float bf2f(unsigned v) { return __uint_as_float(v << 16); }
__device__ __forceinline__ unsigned pack2(float a, float b) { return (unsigned)f2bf(a) | ((unsigned)f2bf(b) << 16); }
__device__ __forceinline__ float lo16(unsigned u) { return __uint_as_float(u << 16); }
__device__ __forceinline__ float hi16(unsigned u) { return __uint_as_float(u & 0xffff0000u); }
__device__ __forceinline__ float sigmoidf_(float x) { return 1.f / (1.f + __expf(-x)); }
__device__ __forceinline__ float softplusf_(float x) { return fmaxf(x, 0.f) + log1pf(__expf(-fabsf(x))); }
__device__ __forceinline__ float siluf_(float x) { return x * sigmoidf_(x); }
__device__ __forceinline__ float geluf_(float x) {
  float u = 0.7978845608028654f * (x + 0.044715f * x * x * x);
  return 0.5f * x * (1.f + tanhf(u));
}
__device__ __forceinline__ float wave_sum(float v) {
  v += __shfl_xor(v, 32); v += __shfl_xor(v, 16); v += __shfl_xor(v, 8);
  v += __shfl_xor(v, 4); v += __shfl_xor(v, 2); v += __shfl_xor(v, 1);
  return v;
}

struct Seq { int row0, T, b, sample; };
__device__ __forceinline__ Seq get_seq(int s) {
  Seq q;
  if (s < 8) { q.row0 = s * 2048; q.T = 2048; q.b = s; q.sample = 0; }
  else { q.b = s - 8; q.row0 = RP + q.b * 8; q.T = 8; q.sample = 1; }
  return q;
}

struct Sched { int xidx, nx, rank, nloc; };
struct GemmArgs { const bf16_t* A1; const bf16_t* A2; const bf16_t* Bt; int lda1, lda2, ksplit, M, N, K; };

template <class Epi>
__device__ __forceinline__ void gemm_run(const GemmArgs g, const Epi epi, char* smem, const Sched sc, int rot = 0) {
  const int tid = threadIdx.x, lane = tid & 63, wid = tid >> 6;
  const int wm = wid >> 1, wn = wid & 1, fr = lane & 15, fq = lane >> 4;
  const int ntn = (g.N + 127) >> 7, nt = (g.M >> 7) * ntn, nk = g.K >> 6;
  const int lr = tid >> 3, lc = tid & 7;
  bf16_t* sbase = (bf16_t*)smem;
  const int ntm = g.M >> 7;
  const int cq = nt / sc.nx, cr = nt - cq * sc.nx;
  const int cnt = sc.xidx < cr ? cq + 1 : cq;
  const int cstart = sc.xidx < cr ? sc.xidx * (cq + 1) : cr * (cq + 1) + (sc.xidx - cr) * cq;
  const int rk = (sc.rank + rot) % sc.nloc;
  int nfull = cnt, rem = 0, S = 1;
  if (Epi::SPLITK) {
    const int r_ = cnt % sc.nloc;
    if (r_ > 0 && 2 * r_ <= sc.nloc) { rem = r_; nfull = cnt - r_; S = min(sc.nloc / r_, nk); }
  }
  const int nitems = (nfull - rk + sc.nloc - 1) / sc.nloc + ((rem > 0 && rk < rem * S) ? 1 : 0);
  for (int it = 0; it < nitems; ++it) {
    int qi = rk + it * sc.nloc, k0 = 0, k1 = nk;
    bool split = false;
    if (qi >= nfull) { qi = nfull + rk / S; const int part = rk - (rk / S) * S; k0 = part * nk / S; k1 = (part + 1) * nk / S; split = true; }
    const int L = cstart + qi;
    const int nig = 8 * ntn, gid = L / nig, fm = gid * 8, gsz = min(ntm - fm, 8), wi = L - gid * nig;
    const int tm = fm + wi % gsz, tn = wi / gsz;
    f32x4 acc[4][4];
#pragma unroll
    for (int mi = 0; mi < 4; ++mi)
#pragma unroll
      for (int ni = 0; ni < 4; ++ni) acc[mi][ni] = (f32x4){0.f, 0.f, 0.f, 0.f};
    uint4 ra00, ra01, ra02, ra03, rb00, rb01, rb02, rb03, ra10, ra11, ra12, ra13, rb10, rb11, rb12, rb13;
#define GL1(KT, RA, RB, P)                                                                          \
      { const int r_ = lr + 32 * (P);                                                               \
        RA = *(const uint4*)(Ab_ + (size_t)(tm * 128 + r_) * lda_ + kk_ + lc * 8);                  \
        int n_ = tn * 128 + r_; n_ = n_ < g.N ? n_ : g.N - 1;                                       \
        RB = *(const uint4*)(g.Bt + (size_t)n_ * g.K + ((KT) << 6) + lc * 8); }
#define GLOAD(KT, S)                                                                                \
    {                                                                                               \
      int kk_ = (KT) << 6; const bf16_t* Ab_ = g.A1; int lda_ = g.lda1;                             \
      if (kk_ >= g.ksplit) { Ab_ = g.A2; lda_ = g.lda2; kk_ -= g.ksplit; }                          \
      GL1(KT, ra##S##0, rb##S##0, 0) GL1(KT, ra##S##1, rb##S##1, 1)                                 \
      GL1(KT, ra##S##2, rb##S##2, 2) GL1(KT, ra##S##3, rb##S##3, 3)                                 \
    }
#define SS1(RA, RB, P)                                                                              \
      { const int r_ = lr + 32 * (P);                                                               \
        const int off_ = r_ * 64 + ((lc ^ ((r_ >> 1) & 7)) << 3);                                   \
        *(uint4*)(sa_ + off_) = RA; *(uint4*)(sb_ + off_) = RB; }
#define SSTORE(BUF, S)                                                                              \
    {                                                                                               \
      bf16_t* sa_ = sbase + (BUF) * 16384; bf16_t* sb_ = sa_ + 8192;                                \
      SS1(ra##S##0, rb##S##0, 0) SS1(ra##S##1, rb##S##1, 1) SS1(ra##S##2, rb##S##2, 2) SS1(ra##S##3, rb##S##3, 3) \
    }
#define COMPUTE(BUF)                                                                                \
    {                                                                                               \
      const bf16_t* sa = sbase + (BUF) * 16384; const bf16_t* sb = sa + 8192;                       \
      _Pragma("unroll") for (int ks = 0; ks < 2; ++ks) {                                            \
        bf16x8 af[4], bfr[4];                                                                       \
        const int ch = ks * 4 + fq;                                                                 \
        _Pragma("unroll") for (int mi = 0; mi < 4; ++mi) {                                          \
          const int r = wm * 64 + mi * 16 + fr;                                                     \
          af[mi] = *(const bf16x8*)(sa + r * 64 + ((ch ^ ((r >> 1) & 7)) << 3));                    \
        }                                                                                           \
        _Pragma("unroll") for (int ni = 0; ni < 4; ++ni) {                                          \
          const int r = wn * 64 + ni * 16 + fr;                                                     \
          bfr[ni] = *(const bf16x8*)(sb + r * 64 + ((ch ^ ((r >> 1) & 7)) << 3));                   \
        }                                                                                           \
        _Pragma("unroll") for (int mi = 0; mi < 4; ++mi)                                            \
          _Pragma("unroll") for (int ni = 0; ni < 4; ++ni)                                          \
            acc[mi][ni] = __builtin_amdgcn_mfma_f32_16x16x32_bf16(bfr[ni], af[mi], acc[mi][ni], 0, 0, 0); \
      }                                                                                             \
    }
    __syncthreads();
    GLOAD(k0, 0);
    GLOAD(min(k0 + 1, k1 - 1), 1);
    SSTORE(0, 0);
    __syncthreads();
    int kt = k0;
    for (; kt + 1 < k1; kt += 2) {
      GLOAD(min(kt + 2, k1 - 1), 0);
      COMPUTE(0);
      SSTORE(1, 1);
      __syncthreads();
      GLOAD(min(kt + 3, k1 - 1), 1);
      COMPUTE(1);
      if (kt + 2 < k1) SSTORE(0, 0);
      __syncthreads();
    }
    if (kt < k1) { COMPUTE(0); __syncthreads(); }
#undef GLOAD
#undef SSTORE
#undef COMPUTE
#undef GL1
#undef SS1
    epi(acc, tm * 128 + wm * 64, tn * 128 + wn * 64, fr, fq, split);
  }
}

template <int VAR, class Epi>
__device__ __forceinline__ void gemm_run_big(const GemmArgs g, const Epi epi, char* smem, const Sched sc) {
  const int tid = threadIdx.x, lane = tid & 63, wid = tid >> 6;
  const int wm = wid >> 1, wn = wid & 1, fr = lane & 15, fq = lane >> 4;
  const int ntn = (g.N + 127) >> 7, ntm = g.M >> 8, nt = ntm * ntn, nk = g.K >> 5;
  const int lr = tid >> 2, lc = tid & 3;
  bf16_t* sbase = (bf16_t*)smem;
  const int cq = nt / sc.nx, cr = nt - cq * sc.nx;
  const int cnt = sc.xidx < cr ? cq + 1 : cq;
  const int cstart = sc.xidx < cr ? sc.xidx * (cq + 1) : cr * (cq + 1) + (sc.xidx - cr) * cq;
  for (int qi = sc.rank; qi < cnt; qi += sc.nloc) {
    const int L = cstart + qi;
    const int nig = 8 * ntn, gid = L / nig, fm = gid * 8, gsz = min(ntm - fm, 8), wi = L - gid * nig;
    const int tm = fm + wi % gsz, tn = wi / gsz;
    f32x4 acc[8][4];
#pragma unroll
    for (int mi = 0; mi < 8; ++mi)
#pragma unroll
      for (int ni = 0; ni < 4; ++ni) acc[mi][ni] = (f32x4){0.f, 0.f, 0.f, 0.f};
    uint4 a00, a01, a02, a03, b00, b01, a10, a11, a12, a13, b10, b11;
    const bf16_t* Ap = g.A1 + (size_t)(tm * 256 + lr) * g.lda1 + lc * 8;
    int nb0 = tn * 128 + lr, nb1 = nb0 + 64;
    nb0 = nb0 < g.N ? nb0 : g.N - 1; nb1 = nb1 < g.N ? nb1 : g.N - 1;
    const bf16_t* Bp0 = g.Bt + (size_t)nb0 * g.K + lc * 8;
    const bf16_t* Bp1 = g.Bt + (size_t)nb1 * g.K + lc * 8;
    const size_t a64 = (size_t)64 * g.lda1;
#define BGLOAD(KT, S)                                                                          \
    { const int ko_ = (VAR == 1) ? 0 : ((KT) << 5);                                            \
      a##S##0 = *(const uint4*)(Ap + ko_);           a##S##1 = *(const uint4*)(Ap + a64 + ko_); \
      a##S##2 = *(const uint4*)(Ap + 2 * a64 + ko_); a##S##3 = *(const uint4*)(Ap + 3 * a64 + ko_); \
      b##S##0 = *(const uint4*)(Bp0 + ko_);          b##S##1 = *(const uint4*)(Bp1 + ko_); }
    const int soff = lr * 32 + ((lc ^ ((lr >> 2) & 3)) << 3);
#define BSSTORE(BUF, S)                                                                        \
    { bf16_t* sa_ = sbase + (BUF) * 12288; bf16_t* sb_ = sa_ + 8192;                           \
      *(uint4*)(sa_ + soff) = a##S##0;        *(uint4*)(sa_ + soff + 2048) = a##S##1;          \
      *(uint4*)(sa_ + soff + 4096) = a##S##2; *(uint4*)(sa_ + soff + 6144) = a##S##3;          \
      *(uint4*)(sb_ + soff) = b##S##0;        *(uint4*)(sb_ + soff + 2048) = b##S##1; }
#define BCOMPUTE(BUF)                                                                          \
    { const bf16_t* sa = sbase + (BUF) * 12288; const bf16_t* sb = sa + 8192;                  \
      bf16x8 bfr[4];                                                                           \
      _Pragma("unroll") for (int ni = 0; ni < 4; ++ni) {                                       \
        const int r = wn * 64 + ni * 16 + fr;                                                  \
        bfr[ni] = *(const bf16x8*)(sb + r * 32 + ((fq ^ ((r >> 2) & 3)) << 3));                \
      }                                                                                        \
      _Pragma("unroll") for (int mi = 0; mi < 8; ++mi) {                                       \
        const int r = wm * 128 + mi * 16 + fr;                                                 \
        const bf16x8 af = *(const bf16x8*)(sa + r * 32 + ((fq ^ ((r >> 2) & 3)) << 3));        \
        _Pragma("unroll") for (int ni = 0; ni < 4; ++ni)                                       \
          acc[mi][ni] = __builtin_amdgcn_mfma_f32_16x16x32_bf16(bfr[ni], af, acc[mi][ni], 0, 0, 0); \
      }                                                                                        \
    }
    if (VAR == 3) {
      const int csw = lc ^ ((lr >> 2) & 3);
      const bf16_t* Aq = g.A1 + (size_t)(tm * 256 + lr) * g.lda1 + csw * 8;
      const bf16_t* Bq0 = g.Bt + (size_t)nb0 * g.K + csw * 8;
      const bf16_t* Bq1 = g.Bt + (size_t)nb1 * g.K + csw * 8;
      const int loff = lr * 32 + lc * 8;
#define BGLDS(KT, BUF)                                                                                     \
      { const int ko_ = (KT) << 5; bf16_t* sa_ = sbase + (BUF) * 12288; bf16_t* sb_ = sa_ + 8192;              \
        __builtin_amdgcn_global_load_lds((const unsigned*)(Aq + ko_), (unsigned*)(sa_ + loff), 16, 0, 0);            \
        __builtin_amdgcn_global_load_lds((const unsigned*)(Aq + a64 + ko_), (unsigned*)(sa_ + loff + 2048), 16, 0, 0); \
        __builtin_amdgcn_global_load_lds((const unsigned*)(Aq + 2 * a64 + ko_), (unsigned*)(sa_ + loff + 4096), 16, 0, 0); \
        __builtin_amdgcn_global_load_lds((const unsigned*)(Aq + 3 * a64 + ko_), (unsigned*)(sa_ + loff + 6144), 16, 0, 0); \
        __builtin_amdgcn_global_load_lds((const unsigned*)(Bq0 + ko_), (unsigned*)(sb_ + loff), 16, 0, 0);           \
        __builtin_amdgcn_global_load_lds((const unsigned*)(Bq1 + ko_), (unsigned*)(sb_ + loff + 2048), 16, 0, 0); }
      __syncthreads();
      BGLDS(0, 0);
#pragma unroll 1
      for (int kt = 0; kt < nk; kt += 2) {
        asm volatile("s_waitcnt vmcnt(0)" ::: "memory");
        __syncthreads();
        if (kt + 1 < nk) BGLDS(kt + 1, 1);
        BCOMPUTE(0);
        if (kt + 1 < nk) {
          asm volatile("s_waitcnt vmcnt(0)" ::: "memory");
          __syncthreads();
          if (kt + 2 < nk) BGLDS(kt + 2, 0);
          BCOMPUTE(1);
        }
      }
      __syncthreads();
#undef BGLDS
    } else {
    __syncthreads();
    BGLOAD(0, 0);
    BGLOAD(min(1, nk - 1), 1);
    BSSTORE(0, 0);
    __syncthreads();
    int kt = 0;
    for (; kt + 1 < nk; kt += 2) {
      BGLOAD(min(kt + 2, nk - 1), 0);
      BCOMPUTE(0);
      if (VAR != 2) BSSTORE(1, 1);
      __syncthreads();
      BGLOAD(min(kt + 3, nk - 1), 1);
      BCOMPUTE(1);
      if (VAR != 2 && kt + 2 < nk) BSSTORE(0, 0);
      __syncthreads();
    }
    if (kt < nk) { BCOMPUTE(0); __syncthreads(); }
    if (VAR == 2 && g.M < 0) { BSSTORE(0, 0); BSSTORE(1, 1); }
    }
#undef BGLOAD
#undef BSSTORE
#undef BCOMPUTE
    epi(acc, tm * 256 + wm * 128, tn * 128 + wn * 64, fr, fq, false);
  }
}

__device__ __forceinline__ void gemm_run_272(const GemmArgs g, const float* srcA, const float* srcB, float* dst, char* smem, const Sched sc) {
  const int tid = threadIdx.x, lane = tid & 63, wid = tid >> 6;
  const int wm = wid >> 1, wn = wid & 1, fr = lane & 15, fq = lane >> 4;
  const int ntn = g.N >> 7, ntm = g.M / 272, nt = ntm * ntn, nk = g.K >> 5;
  const int lr = tid >> 2, lc = tid & 3;
  bf16_t* sbase = (bf16_t*)smem;
  const int cq = nt / sc.nx, cr = nt - cq * sc.nx;
  const int cnt = sc.xidx < cr ? cq + 1 : cq;
  const int cstart = sc.xidx < cr ? sc.xidx * (cq + 1) : cr * (cq + 1) + (sc.xidx - cr) * cq;
  const int mrow0 = wm * 144;
  for (int qi = sc.rank; qi < cnt; qi += sc.nloc) {
    const int L = cstart + qi;
    const int nig = 8 * ntn, gid = L / nig, fm = gid * 8, gsz = min(ntm - fm, 8), wi = L - gid * nig;
    const int tm = fm + wi % gsz, tn = wi / gsz;
    f32x4 acc[9][4];
#pragma unroll
    for (int mi = 0; mi < 9; ++mi)
#pragma unroll
      for (int ni = 0; ni < 4; ++ni) acc[mi][ni] = (f32x4){0.f, 0.f, 0.f, 0.f};
    const int csw = lc ^ ((lr >> 2) & 3);
    const size_t arow = (size_t)(tm * 272 + lr);
    const bf16_t* Bq0 = g.Bt + (size_t)(tn * 128 + lr) * g.K + csw * 8;
    const bf16_t* Bq1 = Bq0 + (size_t)64 * g.K;
    const int loff = lr * 32 + lc * 8;
#define NGLDS(KT, BUF)                                                                                         \
    { int kk_ = (KT) << 5; const bf16_t* Ab_ = g.A1; int lda_ = g.lda1;                                        \
      if (kk_ >= g.ksplit) { Ab_ = g.A2; lda_ = g.lda2; kk_ -= g.ksplit; }                                     \
      const bf16_t* Aq_ = Ab_ + arow * lda_ + csw * 8 + kk_; const size_t a64_ = (size_t)64 * lda_;            \
      bf16_t* sa_ = sbase + (BUF) * 12800; bf16_t* sb_ = sa_ + 8704;                                           \
      __builtin_amdgcn_global_load_lds((const unsigned*)(Aq_), (unsigned*)(sa_ + loff), 16, 0, 0);             \
      __builtin_amdgcn_global_load_lds((const unsigned*)(Aq_ + a64_), (unsigned*)(sa_ + loff + 2048), 16, 0, 0);     \
      __builtin_amdgcn_global_load_lds((const unsigned*)(Aq_ + 2 * a64_), (unsigned*)(sa_ + loff + 4096), 16, 0, 0); \
      __builtin_amdgcn_global_load_lds((const unsigned*)(Aq_ + 3 * a64_), (unsigned*)(sa_ + loff + 6144), 16, 0, 0); \
      if (wid == 0) __builtin_amdgcn_global_load_lds((const unsigned*)(Aq_ + 4 * a64_), (unsigned*)(sa_ + loff + 8192), 16, 0, 0); \
      __builtin_amdgcn_global_load_lds((const unsigned*)(Bq0 + ((KT) << 5)), (unsigned*)(sb_ + loff), 16, 0, 0);     \
      __builtin_amdgcn_global_load_lds((const unsigned*)(Bq1 + ((KT) << 5)), (unsigned*)(sb_ + loff + 2048), 16, 0, 0); }
#define NCOMPUTE(BUF)                                                                          \
    { const bf16_t* sa = sbase + (BUF) * 12800; const bf16_t* sb = sa + 8704;                  \
      bf16x8 bfr[4];                                                                           \
      _Pragma("unroll") for (int ni = 0; ni < 4; ++ni) {                                       \
        const int r = wn * 64 + ni * 16 + fr;                                                  \
        bfr[ni] = *(const bf16x8*)(sb + r * 32 + ((fq ^ ((r >> 2) & 3)) << 3));                \
      }                                                                                        \
      _Pragma("unroll") for (int mi = 0; mi < 9; ++mi) {                                       \
        if (mi < 8 || wm == 0) {                                                               \
          const int r = mrow0 + mi * 16 + fr;                                                  \
          const bf16x8 af = *(const bf16x8*)(sa + r * 32 + ((fq ^ ((r >> 2) & 3)) << 3));      \
          _Pragma("unroll") for (int ni = 0; ni < 4; ++ni)                                     \
            acc[mi][ni] = __builtin_amdgcn_mfma_f32_16x16x32_bf16(bfr[ni], af, acc[mi][ni], 0, 0, 0); \
        }                                                                                      \
      }                                                                                        \
    }
    __syncthreads();
    NGLDS(0, 0);
#pragma unroll 1
    for (int kt = 0; kt < nk; kt += 2) {
      asm volatile("s_waitcnt vmcnt(0)" ::: "memory");
      __syncthreads();
      if (kt + 1 < nk) NGLDS(kt + 1, 1);
      NCOMPUTE(0);
      if (kt + 1 < nk) {
        asm volatile("s_waitcnt vmcnt(0)" ::: "memory");
        __syncthreads();
        if (kt + 2 < nk) NGLDS(kt + 2, 0);
        NCOMPUTE(1);
      }
    }
    __syncthreads();
#undef NGLDS
#undef NCOMPUTE
    const int rb = tm * 272 + mrow0, cb = tn * 128 + wn * 64;
#pragma unroll
    for (int mi = 0; mi < 9; ++mi) {
      if (mi < 8 || wm == 0) {
        const int row = rb + mi * 16 + fr;
        const float* sp = row < RP ? srcA + (size_t)row * 1024 : srcB + (size_t)(row - RP) * 1024;
#pragma unroll
        for (int ni = 0; ni < 4; ++ni) {
          const int col = cb + ni * 16 + fq * 4;
          float4 x = *(const float4*)(sp + col);
          float4 o; o.x = x.x + acc[mi][ni][0]; o.y = x.y + acc[mi][ni][1]; o.z = x.z + acc[mi][ni][2]; o.w = x.w + acc[mi][ni][3];
          *(float4*)(dst + (size_t)row * 1024 + col) = o;
        }
      }
    }
  }
}

struct EpiBf16 {
  static constexpr bool SPLITK = false;
  bf16_t* O; int ld, N;
  template <int MI>
  __device__ __forceinline__ void operator()(f32x4 (&acc)[MI][4], int rb, int cb, int fr, int fq, bool) const {
#pragma unroll
    for (int mi = 0; mi < MI; ++mi) {
      const size_t row = rb + mi * 16 + fr;
#pragma unroll
      for (int ni = 0; ni < 4; ++ni) {
        const int col = cb + ni * 16 + fq * 4;
        if (col < N) {
          uint2 v; v.x = pack2(acc[mi][ni][0], acc[mi][ni][1]); v.y = pack2(acc[mi][ni][2], acc[mi][ni][3]);
          *(uint2*)(O + row * ld + col) = v;
        }
      }
    }
  }
};
template <bool SK>
struct EpiResidualT {
  static constexpr bool SPLITK = SK;
  const float* srcA; const float* srcB; float* dst;
  __device__ __forceinline__ void operator()(f32x4 (&acc)[4][4], int rb, int cb, int fr, int fq, bool split) const {
#pragma unroll
    for (int mi = 0; mi < 4; ++mi) {
      const int row = rb + mi * 16 + fr;
      const float* s = row < RP ? srcA + (size_t)row * 1024 : srcB + (size_t)(row - RP) * 1024;
#pragma unroll
      for (int ni = 0; ni < 4; ++ni) {
        const int col = cb + ni * 16 + fq * 4;
        float* d = dst + (size_t)row * 1024 + col;
        if (SK && split) {
          unsafeAtomicAdd(d + 0, acc[mi][ni][0]); unsafeAtomicAdd(d + 1, acc[mi][ni][1]);
          unsafeAtomicAdd(d + 2, acc[mi][ni][2]); unsafeAtomicAdd(d + 3, acc[mi][ni][3]);
        } else {
          float4 x = *(const float4*)(s + col);
          float4 o; o.x = x.x + acc[mi][ni][0]; o.y = x.y + acc[mi][ni][1]; o.z = x.z + acc[mi][ni][2]; o.w = x.w + acc[mi][ni][3];
          *(float4*)d = o;
        }
      }
    }
  }
};
typedef EpiResidualT<false> EpiResidual;
typedef EpiResidualT<true> EpiResidualSK;
struct EpiGateUp {
  static constexpr bool SPLITK = false;
  bf16_t* act;
  template <int MI>
  __device__ __forceinline__ void operator()(f32x4 (&acc)[MI][4], int rb, int cb, int fr, int fq, bool) const {
#pragma unroll
    for (int mi = 0; mi < MI; ++mi) {
      const size_t row = rb + mi * 16 + fr;
#pragma unroll
      for (int np = 0; np < 2; ++np) {
        const int c = ((cb + np * 32) >> 1) + fq * 4;
        float o[4];
#pragma unroll
        for (int j = 0; j < 4; ++j) o[j] = siluf_(acc[mi][2 * np][j]) * acc[mi][2 * np + 1][j];
        uint2 v; v.x = pack2(o[0], o[1]); v.y = pack2(o[2], o[3]);
        *(uint2*)(act + row * DFF + c) = v;
      }
    }
  }
};
template <int MODE>
struct EpiLora {
  static constexpr bool SPLITK = false;
  bf16_t* O; const float* bias;
  __device__ __forceinline__ void operator()(f32x4 (&acc)[4][4], int rb, int cb, int fr, int fq, bool) const {
#pragma unroll
    for (int mi = 0; mi < 4; ++mi) {
      const size_t row = rb + mi * 16 + fr;
#pragma unroll
      for (int ni = 0; ni < 4; ++ni) {
        const int col = cb + ni * 16 + fq * 4;
        float o[4];
#pragma unroll
        for (int j = 0; j < 4; ++j) {
          float a = acc[mi][ni][j];
          if (MODE == 0) { float x = bias[col + j] + a; o[j] = __expf(-softplusf_(-x) - 0.5f); }
          else if (MODE == 1) { o[j] = sigmoidf_(bias[col + j] + a); }
          else o[j] = a;
        }
        uint2 v; v.x = pack2(o[0], o[1]); v.y = pack2(o[2], o[3]);
        *(uint2*)(O + row * 1024 + col) = v;
      }
    }
  }
};
struct EpiLruGate {
  static constexpr bool SPLITK = false;
  bf16_t* PROJ; bf16_t* GX; const bf16_t* XC; const float* b_r; const float* b_i; const float* lam; int blk;
  __device__ __forceinline__ void operator()(f32x4 (&acc)[4][4], int rb, int cb, int fr, int fq, bool) const {
#pragma unroll
    for (int mi = 0; mi < 4; ++mi) {
      const size_t row = rb + mi * 16 + fr;
#pragma unroll
      for (int np = 0; np < 2; ++np) {
        const int e = blk * 128 + ((cb + np * 32) >> 1) + fq * 4;
        uint2 xu = *(const uint2*)(XC + row * 1024 + e);
        float xv[4] = {lo16(xu.x), hi16(xu.x), lo16(xu.y), hi16(xu.y)};
        float la[4], gx[4];
#pragma unroll
        for (int j = 0; j < 4; ++j) {
          float rg = sigmoidf_(acc[mi][2 * np][j] + b_r[e + j]);
          float ig = sigmoidf_(acc[mi][2 * np + 1][j] + b_i[e + j]);
          la[j] = -8.f * rg * softplusf_(-lam[e + j]);
          gx[j] = ig * xv[j];
        }
        uint2 v; v.x = pack2(la[0], la[1]); v.y = pack2(la[2], la[3]);
        *(uint2*)(PROJ + row * LD1 + D_XBR + e) = v;
        uint2 w; w.x = pack2(gx[0], gx[1]); w.y = pack2(gx[2], gx[3]);
        *(uint2*)(GX + row * 1024 + e) = w;
      }
    }
  }
};

__device__ void conv_wt(const float* src, const float* src2, int ld, int K, int Nout, bf16_t* dst, int paired,
                        char* smem, int& rot) {
  float* tile = (float*)smem;
  const int tid = threadIdx.x;
  const int ntk = K >> 6, ntn = (Nout + 63) >> 6, nt = ntk * ntn;
  const int G = (int)gridDim.x;
  const int start = (int)((blockIdx.x + G - (rot % G)) % G);
  rot += nt;
  for (int t = start; t < nt; t += G) {
    const int tk = t % ntk, tn = t / ntk;
    __syncthreads();
    {
      const int n = tn * 64 + (tid & 63);
      const float* s = src; int c = n;
      if (paired) { const int grp = n >> 5, w = n & 31; c = grp * 16 + (w & 15); s = (w < 16) ? src : src2; }
      const bool ok = n < Nout;
#pragma unroll
      for (int i = 0; i < 16; ++i) {
        const int k = (tid >> 6) + 4 * i;
        tile[k * 65 + (tid & 63)] = ok ? s[(size_t)(tk * 64 + k) * ld + c] : 0.f;
      }
    }
    __syncthreads();
    {
      const int n2 = tid >> 2, kc = (tid & 3) * 16;
      if (tn * 64 + n2 < Nout) {
        unsigned pk[8];
#pragma unroll
        for (int j = 0; j < 8; ++j) pk[j] = pack2(tile[(kc + 2 * j) * 65 + n2], tile[(kc + 2 * j + 1) * 65 + n2]);
        uint4* d = (uint4*)(dst + (size_t)(tn * 64 + n2) * K + tk * 64 + kc);
        d[0] = make_uint4(pk[0], pk[1], pk[2], pk[3]);
        d[1] = make_uint4(pk[4], pk[5], pk[6], pk[7]);
      }
    }
  }
}

__device__ void rmsnorm_phase(const float* xa, const float* xb, const float* g, bf16_t* H) {
  const int lane = threadIdx.x & 63, wid = threadIdx.x >> 6;
  const int nw = gridDim.x * 4;
  for (int row = blockIdx.x * 4 + wid; row < MROWS; row += nw) {
    const float* x = row < RP ? xa + (size_t)row * 1024 : xb + (size_t)(row - RP) * 1024;
    float4 v[4]; float ss = 0.f;
#pragma unroll
    for (int i = 0; i < 4; ++i) {
      v[i] = *(const float4*)(x + lane * 4 + 256 * i);
      ss += v[i].x * v[i].x + v[i].y * v[i].y + v[i].z * v[i].z + v[i].w * v[i].w;
    }
    ss = wave_sum(ss);
    const float rs = rsqrtf(ss * (1.f / 1024.f) + 1e-6f);
#pragma unroll
    for (int i = 0; i < 4; ++i) {
      const int c = lane * 4 + 256 * i;
      float4 gg = *(const float4*)(g + c);
      uint2 o; o.x = pack2(v[i].x * rs * gg.x, v[i].y * rs * gg.y); o.y = pack2(v[i].z * rs * gg.z, v[i].w * rs * gg.w);
      *(uint2*)(H + (size_t)row * 1024 + c) = o;
    }
  }
}
__device__ void final_norm_phase(float* x, const float* g) {
  const int lane = threadIdx.x & 63, wid = threadIdx.x >> 6;
  const int nw = gridDim.x * 4;
  for (int row = blockIdx.x * 4 + wid; row < MROWS; row += nw) {
    float* xr = x + (size_t)row * 1024;
    float4 v[4]; float ss = 0.f;
#pragma unroll
    for (int i = 0; i < 4; ++i) {
      v[i] = *(const float4*)(xr + lane * 4 + 256 * i);
      ss += v[i].x * v[i].x + v[i].y * v[i].y + v[i].z * v[i].z + v[i].w * v[i].w;
    }
    ss = wave_sum(ss);
    const float rs = rsqrtf(ss * (1.f / 1024.f) + 1e-6f);
#pragma unroll
    for (int i = 0; i < 4; ++i) {
      const int c = lane * 4 + 256 * i;
      float4 gg = *(const float4*)(g + c);
      float4 o; o.x = v[i].x * rs * gg.x; o.y = v[i].y * rs * gg.y; o.z = v[i].z * rs * gg.z; o.w = v[i].w * rs * gg.w;
      *(float4*)(xr + c) = o;
    }
  }
}

__device__ void prep0_phase(KP p) {
  const int tid = threadIdx.x;
  const int G = (int)gridDim.x;
  const float* mu = p->in[I_MU];
  const float* wa2 = p->in[I_GLA_WA2];
  const float* ba = p->in[I_GLA_BA];
  for (int row = blockIdx.x; row < MROWS; row += G) {
    int t, b, sample;
    if (row < RP) { t = row & 2047; b = row >> 11; sample = 0; } else { const int rr = row - RP; b = rr >> 3; t = rr & 7; sample = 1; }
    const bf16_t* pr = p->PROJ + (size_t)row * LD0;
    {
      const int j = tid;
      const float c = bf2f(pr[C_LORA + j]);
      float prev = 0.f;
      if (t > 0) prev = bf2f(pr[C_LORA + j - LD0]);
      else if (sample) prev = p->in[I_SSHIFT][(size_t)b * 3328 + 3072 + j];
      const float m = c + (prev - c) * mu[3072 + j];
      float val = m;
      if (j < 64) val = tanhf(m); else if (j >= 128) val = sigmoidf_(m);
      p->L[(size_t)row * 256 + j] = f2bf(val);
    }
    {
      uint4 u0 = *(const uint4*)(pr + C_AL), u1 = *(const uint4*)(pr + C_AL + 8);
      float al[16] = {lo16(u0.x), hi16(u0.x), lo16(u0.y), hi16(u0.y), lo16(u0.z), hi16(u0.z), lo16(u0.w), hi16(u0.w),
                      lo16(u1.x), hi16(u1.x), lo16(u1.y), hi16(u1.y), lo16(u1.z), hi16(u1.z), lo16(u1.w), hi16(u1.w)};
#pragma unroll
      for (int h2 = 0; h2 < 2; ++h2) {
        const int k = tid + 256 * h2;
        float a = ba[k];
#pragma unroll
        for (int i = 0; i < 16; ++i) a += al[i] * wa2[i * 512 + k];
        const float la = -softplusf_(-a) * (1.f / 16.f);
        p->LA[(size_t)row * 512 + k] = f2bf(la);
      }
    }
  }
  for (int s = blockIdx.x; s < NSEQ; s += G) {
    const Seq q = get_seq(s);
    const bf16_t* pr = p->PROJ + (size_t)(q.row0 + q.T - 1) * LD0 + RW0;
    float* o = p->out + (q.sample ? O_SSHIFT + (size_t)q.b * 3328 : O_PSHIFT + (size_t)q.b * 3328);
    for (int j = tid; j < 3328; j += 256) o[j] = bf2f(pr[j]);
  }
}

#ifndef REP_SEL
#define REP_SEL -1
#endif
__device__ __forceinline__ int next_task(unsigned* ctr, char* smem, unsigned n) {
  int* st = (int*)(smem + 65024);
  __syncthreads();
  if (threadIdx.x == 0) *st = (int)atomicAdd(ctr, n);
  __syncthreads();
  return *st;
}

typedef float f32x2 __attribute__((ext_vector_type(2)));
__device__ __forceinline__ float dpp_f(float v, const int ctrl_sel) {
  int x = __float_as_int(v), r;
  if (ctrl_sel == 0) r = __builtin_amdgcn_update_dpp(0, x, 0xB1, 0xF, 0xF, true);
  else if (ctrl_sel == 1) r = __builtin_amdgcn_update_dpp(0, x, 0x4E, 0xF, 0xF, true);
  else if (ctrl_sel == 2) r = __builtin_amdgcn_update_dpp(0, x, 0x141, 0xF, 0xF, true);
  else r = __builtin_amdgcn_update_dpp(0, x, 0x140, 0xF, 0xF, true);
  return __int_as_float(r);
}
__device__ __forceinline__ float sum4(float v) { v += dpp_f(v, 0); v += dpp_f(v, 1); return v; }
__device__ __forceinline__ float sum8(float v) { v = sum4(v); v += dpp_f(v, 2); return v; }
__device__ __forceinline__ float wave_sum3(float v) {
  v = sum8(v); v += dpp_f(v, 3);
  const float a = __int_as_float(__builtin_amdgcn_readlane(__float_as_int(v), 0));
  const float b = __int_as_float(__builtin_amdgcn_readlane(__float_as_int(v), 16));
  const float c = __int_as_float(__builtin_amdgcn_readlane(__float_as_int(v), 32));
  const float d = __int_as_float(__builtin_amdgcn_readlane(__float_as_int(v), 48));
  return (a + b) + (c + d);
}
__device__ __forceinline__ float wave_sum2(float v) {
  v = sum8(v); v += dpp_f(v, 3);
  v += __shfl_xor(v, 16); v += __shfl_xor(v, 32);
  return v;
}

static __device__ __forceinline__ void gla_task(KP p, int s, int h, int cgp, char* smem) {
  float* sq = (float*)smem; float* sk = sq + 2048; float* sea = sk + 2048; float* sv = sea + 2048; float* so = sv + 512;
  const Seq q = get_seq(s);
  const int tid = threadIdx.x, c = tid >> 3, kg = tid & 7;
  const int stt = tid >> 4, skc = tid & 15;
  bf16_t* PROJ = p->PROJ; const bf16_t* LA = p->LA;
  const int nrep_ = q.T > 8 ? ((REP_SEL < 0 || REP_SEL == 0) ? p->rep_long : 1) : p->rep_short;
  for (int rep_ = 0; rep_ < nrep_; ++rep_) {
  const bool last_ = rep_ == nrep_ - 1;
  f32x2 S[8];
  if (q.sample) {
    const float* st = p->in[I_SGLA] + ((size_t)(q.b * 4 + h) * 128) * 256 + cgp * 32 + c;
#pragma unroll
    for (int i = 0; i < 8; ++i) { S[i].x = st[(size_t)(kg * 16 + 2 * i) * 256]; S[i].y = st[(size_t)(kg * 16 + 2 * i + 1) * 256]; }
  } else {
#pragma unroll
    for (int i = 0; i < 8; ++i) S[i] = (f32x2){0.f, 0.f};
  }
  const float qs = 0.08838834764831845f;
  uint4 uq = make_uint4(0, 0, 0, 0), uk = uq, ul = uq; unsigned uv = 0;
#define GLA_PREFETCH(T0)                                                                   \
  {                                                                                        \
    const int ns_ = min(16, q.T - (T0));                                                   \
    if (stt < ns_) {                                                                       \
      const size_t row_ = (size_t)(q.row0 + (T0) + stt);                                   \
      const bf16_t* pr_ = PROJ + row_ * LD0;                                               \
      uq = *(const uint4*)(pr_ + C_Q + h * 128 + skc * 8);                                 \
      uk = *(const uint4*)(pr_ + C_K + h * 128 + skc * 8);                                 \
      ul = *(const uint4*)(LA + row_ * 512 + h * 128 + skc * 8);                           \
      uv = *(const unsigned*)(pr_ + C_V + h * 256 + cgp * 32 + skc * 2);                   \
    }                                                                                      \
  }
  GLA_PREFETCH(0);
  for (int t0 = 0; t0 < q.T; t0 += 16) {
    const int ns = min(16, q.T - t0);
    __syncthreads();
    if (stt < ns) {
      f32x4* dq = (f32x4*)(sq + stt * 128 + skc * 8); f32x4* dk = (f32x4*)(sk + stt * 128 + skc * 8); f32x4* de = (f32x4*)(sea + stt * 128 + skc * 8);
      dq[0] = (f32x4){lo16(uq.x) * qs, hi16(uq.x) * qs, lo16(uq.y) * qs, hi16(uq.y) * qs};
      dq[1] = (f32x4){lo16(uq.z) * qs, hi16(uq.z) * qs, lo16(uq.w) * qs, hi16(uq.w) * qs};
      dk[0] = (f32x4){lo16(uk.x), hi16(uk.x), lo16(uk.y), hi16(uk.y)};
      dk[1] = (f32x4){lo16(uk.z), hi16(uk.z), lo16(uk.w), hi16(uk.w)};
      de[0] = (f32x4){__expf(lo16(ul.x)), __expf(hi16(ul.x)), __expf(lo16(ul.y)), __expf(hi16(ul.y))};
      de[1] = (f32x4){__expf(lo16(ul.z)), __expf(hi16(ul.z)), __expf(lo16(ul.w)), __expf(hi16(ul.w))};
      *(f32x2*)(sv + stt * 32 + skc * 2) = (f32x2){lo16(uv), hi16(uv)};
    }
    __syncthreads();
    if (t0 + 16 < q.T) GLA_PREFETCH(t0 + 16);
    struct GlaKE { float vv; f32x4 k[4], e[4]; };
    auto gla_loadke = [&](const int tt, GlaKE& o) {
      o.vv = sv[tt * 32 + c];
      const f32x4* k4 = (const f32x4*)(sk + tt * 128 + kg * 16);
      const f32x4* e4 = (const f32x4*)(sea + tt * 128 + kg * 16);
#pragma unroll
      for (int u = 0; u < 4; ++u) { o.k[u] = k4[u]; o.e[u] = e4[u]; }
    };
    auto gla_math = [&](const GlaKE& o, const int tt) -> float {
      const f32x4* q4 = (const f32x4*)(sq + tt * 128 + kg * 16);
      f32x4 qq[4];
#pragma unroll
      for (int u = 0; u < 4; ++u) qq[u] = q4[u];
      const f32x2 vv2 = (f32x2){o.vv, o.vv};
      f32x2 oa = (f32x2){0.f, 0.f}, ob = (f32x2){0.f, 0.f};
#pragma unroll
      for (int u = 0; u < 4; ++u) {
        S[2 * u] = o.e[u].xy * S[2 * u] + o.k[u].xy * vv2;         oa = qq[u].xy * S[2 * u] + oa;
        S[2 * u + 1] = o.e[u].zw * S[2 * u + 1] + o.k[u].zw * vv2; ob = qq[u].zw * S[2 * u + 1] + ob;
      }
      oa += ob;
      return sum8(oa.x + oa.y);
    };
    {
      GlaKE ga, gb;
      gla_loadke(0, ga);
#pragma unroll 1
      for (int tt = 0; tt < ns; tt += 2) {
        gla_loadke(tt + 1, gb);
        __builtin_amdgcn_sched_barrier(0);
        { const float o0 = gla_math(ga, tt); if (kg == 0) so[tt * 32 + c] = o0; }
        __builtin_amdgcn_sched_barrier(0);
        gla_loadke(min(tt + 2, ns - 1), ga);
        __builtin_amdgcn_sched_barrier(0);
        { const float o1 = gla_math(gb, tt + 1); if (kg == 0) so[(tt + 1) * 32 + c] = o1; }
        __builtin_amdgcn_sched_barrier(0);
      }
    }
    __syncthreads();
    if (stt < ns && last_) {
      const size_t row = (size_t)(q.row0 + t0 + stt);
      *(unsigned*)(PROJ + row * LD0 + C_V + h * 256 + cgp * 32 + skc * 2) = pack2(so[stt * 32 + skc * 2], so[stt * 32 + skc * 2 + 1]);
    }
  }
#undef GLA_PREFETCH
  float* dst = p->out + (q.sample ? O_SGLA : O_PGLA) + ((size_t)(q.b * 4 + h) * 128) * 256 + cgp * 32 + c;
  if (last_) {
#pragma unroll
  for (int i = 0; i < 8; ++i) { dst[(size_t)(kg * 16 + 2 * i) * 256] = S[i].x; dst[(size_t)(kg * 16 + 2 * i + 1) * 256] = S[i].y; }
  }
  }

}

static __device__ __forceinline__ void rwkv_task(KP p, int s, int h, char* smem) {
  float* sr = (float*)smem; float* sw = sr + 1024; float* skp = sw + 1024; float* snk = skp + 1024; float* sb = snk + 1024;
  float* sv = sb + 1024; float* sy = sv + 1024; float* sbon = sy + 1024; float* scar = sbon + 16;
  float* sg = scar + 384 + 512;
  float* spar = scar + 384;
  const Seq q = get_seq(s);
  const int tid = threadIdx.x, lane = tid & 63, wid = tid >> 6;
  const int i = tid >> 2, jg = tid & 3;
  bf16_t* PROJ = p->PROJ; const bf16_t* EW = p->EW; const bf16_t* AA = p->AA; const bf16_t* GG = p->GG;
  const int nrep_ = q.T > 8 ? ((REP_SEL < 0 || REP_SEL == 1) ? p->rep_long : 1) : p->rep_short;
  for (int rep_ = 0; rep_ < nrep_; ++rep_) {
  const bool last_ = rep_ == nrep_ - 1;
  f32x2 S[8];
  if (q.sample) {
    const f32x4* st = (const f32x4*)(p->in[I_SRWKV] + ((size_t)(q.b * 16 + h) * 64 + i) * 64 + jg * 16);
#pragma unroll
    for (int u = 0; u < 4; ++u) { f32x4 v = st[u]; S[2 * u] = v.xy; S[2 * u + 1] = v.zw; }
  } else {
#pragma unroll
    for (int u = 0; u < 8; ++u) S[u] = (f32x2){0.f, 0.f};
  }
  __syncthreads();
  if (tid < 192) {
    const int a = tid >> 6, j = tid & 63;
    scar[a * 64 + j] = q.sample ? p->in[I_SSHIFT][(size_t)q.b * 3328 + a * 1024 + h * 64 + j] : 0.f;
  }
  const int col = h * 64 + lane;
  if (tid < 64) {
    spar[lane] = p->in[I_MU][col]; spar[64 + lane] = p->in[I_MU][1024 + col]; spar[128 + lane] = p->in[I_MU][2048 + col];
    spar[192 + lane] = p->in[I_KK][col]; spar[256 + lane] = p->in[I_KA][col]; spar[320 + lane] = p->in[I_RK][col];
    spar[384 + lane] = p->in[I_LNW][col]; spar[448 + lane] = p->in[I_LNB][col];
  }
  unsigned xr[4], xk[4], xv[4], xe[4], xa[4], xg[4], yr = 0, yk = 0, yv = 0;
#pragma unroll
  for (int u = 0; u < 4; ++u) { xr[u] = xk[u] = xv[u] = xe[u] = xa[u] = xg[u] = 0; }
#define RWKV_PREFETCH(T0)                                                                  \
  {                                                                                        \
    const int ns_ = min(16, q.T - (T0));                                                   \
    _Pragma("unroll") for (int u = 0; u < 4; ++u) {                                        \
      const int tt_ = 4 * wid + u;                                                         \
      if (tt_ < ns_) {                                                                     \
        const size_t row_ = (size_t)(q.row0 + (T0) + tt_);                                 \
        const bf16_t* pr_ = PROJ + row_ * LD0;                                             \
        xr[u] = pr_[C_R + col]; xk[u] = pr_[C_KR + col]; xv[u] = pr_[C_VR + col];          \
        xe[u] = EW[row_ * 1024 + col]; xa[u] = AA[row_ * 1024 + col]; xg[u] = GG[row_ * 1024 + col]; \
      }                                                                                    \
    }                                                                                      \
    if (wid > 0 && 4 * wid < ns_) {                                                        \
      const bf16_t* pr_ = PROJ + (size_t)(q.row0 + (T0) + 4 * wid - 1) * LD0;              \
      yr = pr_[C_R + col]; yk = pr_[C_KR + col]; yv = pr_[C_VR + col];                     \
    }                                                                                      \
  }
  RWKV_PREFETCH(0);
  int par = 0;
  for (int t0 = 0; t0 < q.T; t0 += 16, par ^= 1) {
    const int ns = min(16, q.T - t0);
    __syncthreads();
    {
      const float mu_r = spar[lane], mu_k = spar[64 + lane], mu_v = spar[128 + lane];
      const float k_k = spar[192 + lane], k_a = spar[256 + lane], r_k = spar[320 + lane];
      float pr_r, pr_k, pr_v;
      if (wid > 0) { pr_r = bf2f(yr); pr_k = bf2f(yk); pr_v = bf2f(yv); }
      else { pr_r = scar[par * 192 + lane]; pr_k = scar[par * 192 + 64 + lane]; pr_v = scar[par * 192 + 128 + lane]; }
#pragma unroll
      for (int u = 0; u < 4; ++u) {
        const int tt = 4 * wid + u;
        const float cr = bf2f(xr[u]), ck = bf2f(xk[u]), cv = bf2f(xv[u]);
        if (tt < ns) {
          if (tt == ns - 1) { scar[(par ^ 1) * 192 + lane] = cr; scar[(par ^ 1) * 192 + 64 + lane] = ck; scar[(par ^ 1) * 192 + 128 + lane] = cv; }
          const float r = cr + (pr_r - cr) * mu_r, kr = ck + (pr_k - ck) * mu_k, vr = cv + (pr_v - cv) * mu_v;
          const float ew = bf2f(xe[u]);
          const float a = bf2f(xa[u]);
          const float w = __expf(-ew);
          const float kkr = kr * k_k;
          const float ss = wave_sum3(kkr * kkr);
          const float kk = kkr * rsqrtf(fmaxf(ss, 1e-24f));
          const float kp = kr * (1.f + (a - 1.f) * k_a);
          const float bon = wave_sum3(r * kp * r_k);
          sr[tt * 64 + lane] = r; sw[tt * 64 + lane] = w; skp[tt * 64 + lane] = kp; snk[tt * 64 + lane] = -kk;
          sb[tt * 64 + lane] = kk * a; sv[tt * 64 + lane] = vr; sg[tt * 64 + lane] = bf2f(xg[u]);
          if (lane == 0) sbon[tt] = bon;
        }
        pr_r = cr; pr_k = ck; pr_v = cv;
      }
    }
    __syncthreads();
    if (t0 + 16 < q.T) RWKV_PREFETCH(t0 + 16);
    struct RwN { float vi; f32x4 n[4]; };
    struct RwW { f32x4 w[4], b[4], k[4], r[4]; };
    auto rw_loadn = [&](const int tt, RwN& o) {
      o.vi = sv[tt * 64 + i];
      const f32x4* n4 = (const f32x4*)(snk + tt * 64 + jg * 16);
#pragma unroll
      for (int u = 0; u < 4; ++u) o.n[u] = n4[u];
    };
    auto rw_loadw = [&](const int tt, RwW& o) {
      const f32x4* w4 = (const f32x4*)(sw + tt * 64 + jg * 16);
      const f32x4* b4 = (const f32x4*)(sb + tt * 64 + jg * 16);
      const f32x4* k4 = (const f32x4*)(skp + tt * 64 + jg * 16);
      const f32x4* r4 = (const f32x4*)(sr + tt * 64 + jg * 16);
#pragma unroll
      for (int u = 0; u < 4; ++u) { o.w[u] = w4[u]; o.b[u] = b4[u]; o.k[u] = k4[u]; o.r[u] = r4[u]; }
    };
    auto rw_sa = [&](const RwN& o, const RwW& w) -> float {
      f32x2 saa = (f32x2){0.f, 0.f}, sab = (f32x2){0.f, 0.f};
#pragma unroll
      for (int u = 0; u < 4; ++u) { saa = S[2 * u] * o.n[u].xy + saa; sab = S[2 * u + 1] * o.n[u].zw + sab; }
      saa += sab;
      const float sa = sum4(saa.x + saa.y);
      const f32x2 viv = (f32x2){o.vi, o.vi};
#pragma unroll
      for (int u = 0; u < 4; ++u) {
        S[2 * u] = S[2 * u] * w.w[u].xy + viv * w.k[u].xy;
        S[2 * u + 1] = S[2 * u + 1] * w.w[u].zw + viv * w.k[u].zw;
      }
      return sa;
    };
    auto rw_upd = [&](const RwW& o, const float sa) -> float {
      const f32x2 sav = (f32x2){sa, sa};
      f32x2 ya = (f32x2){0.f, 0.f}, yb = (f32x2){0.f, 0.f}, yc = (f32x2){0.f, 0.f}, yd = (f32x2){0.f, 0.f};
#pragma unroll
      for (int u = 0; u < 4; u += 2) {
        S[2 * u] = sav * o.b[u].xy + S[2 * u];             ya = S[2 * u] * o.r[u].xy + ya;
        S[2 * u + 1] = sav * o.b[u].zw + S[2 * u + 1];     yb = S[2 * u + 1] * o.r[u].zw + yb;
        S[2 * u + 2] = sav * o.b[u + 1].xy + S[2 * u + 2]; yc = S[2 * u + 2] * o.r[u + 1].xy + yc;
        S[2 * u + 3] = sav * o.b[u + 1].zw + S[2 * u + 3]; yd = S[2 * u + 3] * o.r[u + 1].zw + yd;
      }
      ya += yb; yc += yd; ya += yc;
      return sum4(ya.x + ya.y);
    };
    {
      RwN na; RwW wv;
      rw_loadn(0, na);
#pragma unroll 1
      for (int tt = 0; tt < ns; ++tt) {
        rw_loadw(tt, wv);
        __builtin_amdgcn_sched_barrier(0);
        const float sa0 = rw_sa(na, wv);
        __builtin_amdgcn_sched_barrier(0);
        rw_loadn(min(tt + 1, ns - 1), na);
        __builtin_amdgcn_sched_barrier(0);
        const float y0 = rw_upd(wv, sa0);
        if (jg == 0) sy[tt * 64 + i] = y0;
        __builtin_amdgcn_sched_barrier(0);
      }
    }
    __syncthreads();
#pragma unroll
    for (int u = 0; u < 4; ++u) {
      const int tt = 4 * wid + u;
      if (tt < ns) {
        const size_t row = (size_t)(q.row0 + t0 + tt);
        const float y = sy[tt * 64 + lane];
        const float s1 = wave_sum3(y), s2 = wave_sum3(y * y);
        const float mean = s1 * (1.f / 64.f);
        const float var = fmaxf(s2 * (1.f / 64.f) - mean * mean, 0.f);
        const float gn = (y - mean) * rsqrtf(var + 64e-5f) * spar[384 + lane] + spar[448 + lane];
        const float o = (gn + sbon[tt] * sv[tt * 64 + lane]) * sg[tt * 64 + lane];
        if (last_) PROJ[row * LD0 + C_R + col] = f2bf(o);
      }
    }
  }
#undef RWKV_PREFETCH
  f32x4* dst = (f32x4*)(p->out + (q.sample ? O_SRWKV : O_PRWKV) + ((size_t)(q.b * 16 + h) * 64 + i) * 64 + jg * 16);
  if (last_) {
#pragma unroll
  for (int u = 0; u < 4; ++u) dst[u] = (f32x4){S[2 * u].x, S[2 * u].y, S[2 * u + 1].x, S[2 * u + 1].y};
  }
  }

}

__device__ void scan0_phase(KP p, char* smem) {
  const int NL = 384, NS = 2048 + 4096;
  const int G = (int)gridDim.x, b = (int)blockIdx.x;
  int next_long, long_stride;
  if (G >= 512) { next_long = b < 256 ? b : ((b >= 384 && b < 512) ? b - 128 : NL); long_stride = 1 << 20; }
  else { next_long = b; long_stride = G; }
  int cur = 0, batch_end = 0;
  for (;;) {
    int t;
    if (next_long < NL) { t = next_long; next_long += long_stride; }
    else {
      if (cur >= batch_end) {
        const int base = next_task(p->ctr + 0, smem, 8);
        if (base >= NS) break;
        cur = base; batch_end = min(base + 8, NS);
      }
      t = NL + cur++;
    }
    int is_rwkv, sq, hh, cg_ = 0;
    if (t < 128) { is_rwkv = 1; sq = t >> 4; hh = t & 15; }
    else if (t < 384) { t -= 128; is_rwkv = 0; sq = t >> 5; hh = (t >> 3) & 3; cg_ = t & 7; }
    else if (t < 384 + 2048) { t -= 384; is_rwkv = 1; sq = 8 + (t >> 4); hh = t & 15; }
    else { t -= 384 + 2048; is_rwkv = 0; sq = 8 + (t >> 5); hh = (t >> 3) & 3; cg_ = t & 7; }
    if (is_rwkv) rwkv_task(p, sq, hh, smem); else gla_task(p, sq, hh, cg_, smem);
  }
}

__device__ void gla_norm_phase(KP p) {
  const int lane = threadIdx.x & 63, wid = threadIdx.x >> 6;
  const int nw = gridDim.x * 4;
  const float* gn = p->in[I_GLA_GN];
  const float4 g4 = *(const float4*)(gn + lane * 4);
  for (int it = blockIdx.x * 4 + wid; it < MROWS * 4; it += nw) {
    const size_t row = it >> 2; const int h = it & 3;
    bf16_t* po = p->PROJ + row * LD0 + C_V + h * 256 + lane * 4;
    const uint2 uo = *(const uint2*)po;
    const uint2 ug = *(const uint2*)(p->PROJ + row * LD0 + C_OG + h * 256 + lane * 4);
    const float o0 = lo16(uo.x), o1 = hi16(uo.x), o2 = lo16(uo.y), o3 = hi16(uo.y);
    const float ss = wave_sum(o0 * o0 + o1 * o1 + o2 * o2 + o3 * o3);
    const float rs = rsqrtf(ss * (1.f / 256.f) + 1e-5f);
    uint2 r;
    r.x = pack2(o0 * rs * g4.x * siluf_(lo16(ug.x)), o1 * rs * g4.y * siluf_(hi16(ug.x)));
    r.y = pack2(o2 * rs * g4.z * siluf_(lo16(ug.y)), o3 * rs * g4.w * siluf_(hi16(ug.y)));
    *(uint2*)po = r;
  }
}

__device__ void prep1_phase(KP p) {
  const int tid = threadIdx.x;
  const int G = (int)gridDim.x;
  for (int row = blockIdx.x; row < MROWS; row += G) {
    int t, b, sample;
    if (row < RP) { t = row & 2047; b = row >> 11; sample = 0; } else { const int rr = row - RP; b = rr >> 3; t = rr & 7; sample = 1; }
    const bf16_t* pr = p->PROJ + (size_t)row * LD1;
    for (int c = tid; c < 2560; c += 256) {
      const bool lru = c < 1024;
      const int ch = lru ? c : c - 1024;
      const int colx = lru ? D_XBR + ch : D_XBC + ch;
      const int nch = lru ? 1024 : 1536;
      const float* cw = lru ? p->in[I_LCW] : p->in[I_SCW];
      const float* stc = lru ? p->in[I_SLRUC] : p->in[I_SSSDC];
      float acc = (lru ? p->in[I_LCB] : p->in[I_SCB])[ch];
#pragma unroll
      for (int m = 0; m < 4; ++m) {
        float u = 0.f;
        if (t - m >= 0) u = bf2f(pr[colx - m * LD1]);
        else if (sample) u = stc[((size_t)b * 3 + (3 + t - m)) * nch + ch];
        acc += u * cw[(3 - m) * nch + ch];
      }
      if (lru) p->XC[(size_t)row * 1024 + ch] = f2bf(acc);
      else p->XBC[(size_t)row * 1536 + ch] = f2bf(siluf_(acc));
    }
    if (tid < 16) p->DT[(size_t)row * 16 + tid] = softplusf_(bf2f(pr[D_DT + tid]) + p->in[I_DTB][tid]);
  }
  for (int s = blockIdx.x; s < NSEQ; s += G) {
    const Seq q = get_seq(s);
    for (int e = tid; e < 3 * 2560; e += 256) {
      const int j = e / 2560, c = e - j * 2560;
      const size_t row = (size_t)(q.row0 + q.T - 3 + j);
      if (c < 1024) {
        float* o = p->out + (q.sample ? O_SLRUC : O_PLRUC) + ((size_t)q.b * 3 + j) * 1024 + c;
        *o = bf2f(p->PROJ[row * LD1 + D_XBR + c]);
      } else {
        const int ch = c - 1024;
        float* o = p->out + (q.sample ? O_SSSDC : O_PSSDC) + ((size_t)q.b * 3 + j) * 1536 + ch;
        *o = bf2f(p->PROJ[row * LD1 + D_XBC + ch]);
      }
    }
  }
}

__device__ __forceinline__ float fast_tanh(float u) { return 1.f - 2.f / (__expf(2.f * u) + 1.f); }
static __device__ __forceinline__ void lru_task(KP p, int s, int cq) {
  const Seq q = get_seq(s);
  const int ch = cq * 256 + threadIdx.x;
  bf16_t* PROJ = p->PROJ; const bf16_t* GX = p->GX;
  const int nrep_ = q.T > 8 ? ((REP_SEL < 0 || REP_SEL == 2) ? p->rep_long : 1) : p->rep_short;
  for (int rep_ = 0; rep_ < nrep_; ++rep_) {
  const bool last_ = rep_ == nrep_ - 1;
  float h = q.sample ? p->in[I_SLRU][(size_t)q.b * 1024 + ch] : 0.f;
  unsigned nla[8], ngx[8], ngt[8];
#define LRU_PREFETCH(T0)                                                          \
  _Pragma("unroll") for (int u = 0; u < 8; ++u) {                                 \
    const size_t row_ = (size_t)(q.row0 + (T0) + u);                              \
    nla[u] = PROJ[row_ * LD1 + D_XBR + ch]; ngx[u] = GX[row_ * 1024 + ch]; ngt[u] = PROJ[row_ * LD1 + D_GATE + ch]; \
  }
  LRU_PREFETCH(0);
  for (int t0 = 0; t0 < q.T; t0 += 8) {
    float a[8], bt[8], ge[8];
#pragma unroll
    for (int u = 0; u < 8; ++u) {
      const float la = bf2f(nla[u]), gx = bf2f(ngx[u]), gt = bf2f(ngt[u]);
      a[u] = __expf(la);
      const float x = 2.f * la;
      const float om = (x > -0.1f) ? -x * (1.f + x * (0.5f + x * (0.16666667f + x * 0.041666668f))) : 1.f - __expf(x);
      bt[u] = __builtin_amdgcn_sqrtf(fmaxf(om, 0.f)) * gx;
      const float uu = 0.7978845608028654f * (gt + 0.044715f * gt * gt * gt);
      ge[u] = 0.5f * gt * (1.f + fast_tanh(uu));
    }
    if (t0 + 8 < q.T) LRU_PREFETCH(t0 + 8);
#pragma unroll
    for (int u = 0; u < 8; ++u) {
      const size_t row = (size_t)(q.row0 + t0 + u);
      h = fmaf(a[u], h, bt[u]);
      if (last_) PROJ[row * LD1 + D_GATE + ch] = f2bf(h * ge[u]);
    }
  }
#undef LRU_PREFETCH
  if (last_) p->out[(q.sample ? O_SLRU : O_PLRU) + (size_t)q.b * 1024 + ch] = h;
  }

}

static __device__ __forceinline__ void ssd_task(KP p, int s, int h, int pg, char* smem) {
  float* sB = (float*)smem; float* sC = sB + 4096; float* sx = sC + 4096; float* so = sx + 1024; float* sda = so + 1024; float* sdt = sda + 32;
  const Seq q = get_seq(s);
  const int tid = threadIdx.x, c = tid >> 3, ng = tid & 7;
  const int stt = tid >> 4, skc = tid & 15;
  const int g = h >> 3;
  bf16_t* PROJ = p->PROJ; const bf16_t* XBC = p->XBC; const float* DT = p->DT;
  f32x2 S[8];
  if (q.sample) {
    const f32x4* st = (const f32x4*)(p->in[I_SSSD] + ((size_t)(q.b * 16 + h) * 64 + pg * 32 + c) * 128 + ng * 16);
#pragma unroll
    for (int u = 0; u < 4; ++u) { f32x4 v = st[u]; S[2 * u] = v.xy; S[2 * u + 1] = v.zw; }
  } else {
#pragma unroll
    for (int u = 0; u < 8; ++u) S[u] = (f32x2){0.f, 0.f};
  }
  const float Ah = -__expf(p->in[I_ALOG][h]);
  const float Dh = p->in[I_SD][h];
  uint4 ub0 = make_uint4(0, 0, 0, 0), uc0 = ub0, ub1 = ub0, uc1 = ub0; unsigned ux0 = 0, uz0 = 0, ux1 = 0, uz1 = 0; float udt0 = 0.f, udt1 = 0.f;
#define SSD_PF1(T0, R, UB, UC, UX, UZ, UDT)                                                \
    if ((R) < ns_) {                                                                       \
      const size_t row_ = (size_t)(q.row0 + (T0) + (R));                                   \
      const bf16_t* px_ = XBC + row_ * 1536;                                               \
      UB = *(const uint4*)(px_ + 1024 + g * 128 + skc * 8);                                \
      UC = *(const uint4*)(px_ + 1280 + g * 128 + skc * 8);                                \
      UX = *(const unsigned*)(px_ + h * 64 + pg * 32 + skc * 2);                           \
      UZ = *(const unsigned*)(PROJ + row_ * LD1 + D_Z + h * 64 + pg * 32 + skc * 2);       \
      UDT = DT[row_ * 16 + h];                                                             \
    }
#define SSD_PREFETCH(T0)                                                                   \
  { const int ns_ = min(32, q.T - (T0));                                                   \
    SSD_PF1(T0, stt, ub0, uc0, ux0, uz0, udt0) SSD_PF1(T0, stt + 16, ub1, uc1, ux1, uz1, udt1) }
#define SSD_ST1(R, UB, UC, UX, UDT)                                                        \
    if ((R) < ns) {                                                                        \
      f32x4* db = (f32x4*)(sB + (R) * 128 + skc * 8); f32x4* dc = (f32x4*)(sC + (R) * 128 + skc * 8); \
      db[0] = (f32x4){lo16(UB.x), hi16(UB.x), lo16(UB.y), hi16(UB.y)};                     \
      db[1] = (f32x4){lo16(UB.z), hi16(UB.z), lo16(UB.w), hi16(UB.w)};                     \
      dc[0] = (f32x4){lo16(UC.x), hi16(UC.x), lo16(UC.y), hi16(UC.y)};                     \
      dc[1] = (f32x4){lo16(UC.z), hi16(UC.z), lo16(UC.w), hi16(UC.w)};                     \
      *(f32x2*)(sx + (R) * 32 + skc * 2) = (f32x2){lo16(UX), hi16(UX)};                    \
      if (skc == 0) { sdt[(R)] = UDT; sda[(R)] = __expf(UDT * Ah); }                       \
    }
  SSD_PREFETCH(0);
  for (int t0 = 0; t0 < q.T; t0 += 32) {
    const int ns = min(32, q.T - t0);
    __syncthreads();
    const unsigned zc0 = uz0, zc1 = uz1;
    SSD_ST1(stt, ub0, uc0, ux0, udt0)
    SSD_ST1(stt + 16, ub1, uc1, ux1, udt1)
    __syncthreads();
    if (t0 + 32 < q.T) SSD_PREFETCH(t0 + 32);
    struct SsdOps { float xv, da, dt; f32x4 b[4], c[4]; };
    auto ssd_load = [&](const int tt, SsdOps& o) {
      o.xv = sx[tt * 32 + c]; o.da = sda[tt]; o.dt = sdt[tt];
      const f32x4* b4 = (const f32x4*)(sB + tt * 128 + ng * 16);
      const f32x4* c4 = (const f32x4*)(sC + tt * 128 + ng * 16);
#pragma unroll
      for (int u = 0; u < 4; ++u) { o.b[u] = b4[u]; o.c[u] = c4[u]; }
    };
    auto ssd_math = [&](const SsdOps& o) -> float {
      const float dx = o.dt * o.xv;
      const f32x2 da2 = (f32x2){o.da, o.da}, dx2 = (f32x2){dx, dx};
      f32x2 ya = (f32x2){0.f, 0.f}, yb = (f32x2){0.f, 0.f};
#pragma unroll
      for (int u = 0; u < 4; ++u) {
        S[2 * u] = da2 * S[2 * u] + dx2 * o.b[u].xy;         ya = o.c[u].xy * S[2 * u] + ya;
        S[2 * u + 1] = da2 * S[2 * u + 1] + dx2 * o.b[u].zw; yb = o.c[u].zw * S[2 * u + 1] + yb;
      }
      ya += yb;
      return sum8(ya.x + ya.y) + Dh * o.xv;
    };
    if (ns == 32) {
      SsdOps oa, ob;
      ssd_load(0, oa);
#pragma unroll
      for (int hh = 0; hh < 2; ++hh) {
        float yv[16];
#pragma unroll
        for (int tt = 0; tt < 16; tt += 2) {
          ssd_load(hh * 16 + tt + 1, ob);
          __builtin_amdgcn_sched_barrier(0);
          yv[tt] = ssd_math(oa);
          __builtin_amdgcn_sched_barrier(0);
          ssd_load(min(hh * 16 + tt + 2, 31), oa);
          __builtin_amdgcn_sched_barrier(0);
          yv[tt + 1] = ssd_math(ob);
          __builtin_amdgcn_sched_barrier(0);
        }
        if (ng == 0) {
#pragma unroll
          for (int tt = 0; tt < 16; ++tt) so[(hh * 16 + tt) * 32 + c] = yv[tt];
        }
      }
    } else {
      for (int tt = 0; tt < ns; ++tt) { SsdOps o; ssd_load(tt, o); const float y = ssd_math(o); if (ng == 0) so[tt * 32 + c] = y; }
    }
    __syncthreads();
    if (stt < ns) {
      const size_t row = (size_t)(q.row0 + t0 + stt);
      *(unsigned*)(PROJ + row * LD1 + D_Z + h * 64 + pg * 32 + skc * 2) =
          pack2(so[stt * 32 + skc * 2] * siluf_(lo16(zc0)), so[stt * 32 + skc * 2 + 1] * siluf_(hi16(zc0)));
    }
    if (stt + 16 < ns) {
      const size_t row = (size_t)(q.row0 + t0 + stt + 16);
      *(unsigned*)(PROJ + row * LD1 + D_Z + h * 64 + pg * 32 + skc * 2) =
          pack2(so[(stt + 16) * 32 + skc * 2] * siluf_(lo16(zc1)), so[(stt + 16) * 32 + skc * 2 + 1] * siluf_(hi16(zc1)));
    }
  }
#undef SSD_PREFETCH
#undef SSD_PF1
#undef SSD_ST1
  f32x4* dst = (f32x4*)(p->out + (q.sample ? O_SSSD : O_PSSD) + ((size_t)(q.b * 16 + h) * 64 + pg * 32 + c) * 128 + ng * 16);
#pragma unroll
  for (int u = 0; u < 4; ++u) dst[u] = (f32x4){S[2 * u].x, S[2 * u].y, S[2 * u + 1].x, S[2 * u + 1].y};
}

__device__ void scan1_phase(KP p, char* smem) {
  const int NL = 288, NS = 4096 + 512;
  const int G = (int)gridDim.x, b = (int)blockIdx.x;
  int next_long = b;
  int cur = 0, batch_end = 0;
  for (;;) {
    int t;
    if (next_long < NL) { t = next_long; next_long += G; }
    else {
      if (cur >= batch_end) {
        const int base = next_task(p->ctr + 1, smem, 8);
        if (base >= NS) break;
        cur = base; batch_end = min(base + 8, NS);
      }
      t = NL + cur++;
    }
    int is_lru, sq, a1, a2 = 0;
    if (t < 32) { is_lru = 1; sq = t >> 2; a1 = t & 3; }
    else if (t < 288) { t -= 32; is_lru = 0; sq = t >> 5; a1 = (t >> 1) & 15; a2 = t & 1; }
    else if (t < 288 + 4096) { t -= 288; is_lru = 0; sq = 8 + (t >> 5); a1 = (t >> 1) & 15; a2 = t & 1; }
    else { t -= 288 + 4096; is_lru = 1; sq = 8 + (t >> 2); a1 = t & 3; }
    if (is_lru) lru_task(p, sq, a1); else ssd_task(p, sq, a1, a2, smem);
  }
}

__device__ void ssd_norm_phase(KP p) {
  const int lane = threadIdx.x & 63, wid = threadIdx.x >> 6;
  const int nw = gridDim.x * 4;
  const float* nwt = p->in[I_SNW];
  for (int it = blockIdx.x * 4 + wid; it < MROWS * 2; it += nw) {
    const size_t row = it >> 1; const int g = it & 1;
    bf16_t* po = p->PROJ + row * LD1 + D_Z + g * 512 + lane * 8;
    const uint4 u = *(const uint4*)po;
    float v[8] = {lo16(u.x), hi16(u.x), lo16(u.y), hi16(u.y), lo16(u.z), hi16(u.z), lo16(u.w), hi16(u.w)};
    float ss = 0.f;
#pragma unroll
    for (int j = 0; j < 8; ++j) ss += v[j] * v[j];
    ss = wave_sum(ss);
    const float rs = rsqrtf(ss * (1.f / 512.f) + 1e-5f);
    const float* w = nwt + g * 512 + lane * 8;
    uint4 r;
    r.x = pack2(v[0] * rs * w[0], v[1] * rs * w[1]); r.y = pack2(v[2] * rs * w[2], v[3] * rs * w[3]);
    r.z = pack2(v[4] * rs * w[4], v[5] * rs * w[5]); r.w = pack2(v[6] * rs * w[6], v[7] * rs * w[7]);
    *(uint4*)po = r;
  }
}

#define XB_TMO      128
#define XB_XCNT(j)  (256  + 64 * (j))
#define XB_XSUB(j)  (1280 + 64 * (j))
#define XB_XGEN(j)  (2304 + 64 * (j))
#define XB_TOP      3328
#define XB_TOPGEN   3392
#define XCD_BAR_WORDS 3456
#define XB_SPIN_CAP (1u << 18)
__device__ __forceinline__ unsigned xb_ld(unsigned* p)              { return __hip_atomic_load(p, __ATOMIC_RELAXED, __HIP_MEMORY_SCOPE_AGENT); }
__device__ __forceinline__ unsigned xb_add(unsigned* p, unsigned v) { return __hip_atomic_fetch_add(p, v, __ATOMIC_RELAXED, __HIP_MEMORY_SCOPE_AGENT); }
__device__ __forceinline__ unsigned xb_xcc_id() { return (unsigned)__builtin_amdgcn_s_getreg((3 << 11) | 20) & 0xFu; }
#define XB_SPIN(cond, bar) do { unsigned _sp = 0; while (cond) { __builtin_amdgcn_s_sleep(1); \
    if ((++_sp & 255u) == 0u) { if (xb_ld(&(bar)[XB_TMO])) break; if (_sp > XB_SPIN_CAP) { atomicAdd(&(bar)[XB_TMO], 1u); break; } } } } while (0)

__device__ __forceinline__ void xcd_barrier(unsigned* bar, unsigned x, unsigned nloc, unsigned nx) {
  asm volatile("s_waitcnt vmcnt(0)" ::: "memory");
  __syncthreads();
  if (threadIdx.x == 0) {
    __builtin_amdgcn_s_waitcnt(0);
    const unsigned old = xb_add(&bar[XB_XSUB(x)], 1u);
    const unsigned gen = old / nloc;
    if (old + 1u == (gen + 1u) * nloc) {
      __builtin_amdgcn_fence(__ATOMIC_RELEASE, "agent");
      asm volatile("s_waitcnt vmcnt(0)" ::: "memory");
      const unsigned og = xb_add(&bar[XB_TOP], 1u);
      const unsigned tg = og / nx;
      if (og + 1u == (tg + 1u) * nx) xb_add(&bar[XB_TOPGEN], 1u);
      else XB_SPIN(xb_ld(&bar[XB_TOPGEN]) == tg, bar);
      __builtin_amdgcn_fence(__ATOMIC_ACQUIRE, "agent");
      xb_add(&bar[XB_XGEN(x)], 1u);
      asm volatile("s_waitcnt vmcnt(0)" ::: "memory");
    } else {
      XB_SPIN(xb_ld(&bar[XB_XGEN(x)]) == gen, bar);
      __builtin_amdgcn_fence(__ATOMIC_ACQUIRE, "agent");
      asm volatile("s_waitcnt vmcnt(0)" ::: "memory");
    }
  }
  __syncthreads();
}

constexpr int N_PHASES = 21;
#ifndef PH_MASK
#define PH_MASK 0xffffffffu
#endif
#define PH_ON(k) (((PH_MASK) >> (k)) & 1u)

template <int PH>
__device__ __forceinline__ void run_phase(KP p, char* smem, const Sched sc) {
  float* X = p->out;
  switch (PH) {
    case 0: if (PH_ON(0)) {
      if (blockIdx.x == 0 && threadIdx.x == 0) { p->ctr[0] = 0u; p->ctr[1] = 0u; p->ctr[2] = 0u; p->ctr[3] = 0u; }
      int rot = 0;
      conv_wt(p->in[I_WIN0], nullptr, LD0, 1024, LD0, p->Win0t, 0, smem, rot);
      conv_wt(p->in[I_WOUT0], nullptr, 1024, 2048, 1024, p->Wout0t, 0, smem, rot);
      conv_wt(p->in[I_WIN1], nullptr, LD1, 1024, LD1, p->Win1t, 0, smem, rot);
      conv_wt(p->in[I_WOUT1], nullptr, 1024, 2048, 1024, p->Wout1t, 0, smem, rot);
      conv_wt(p->in[I_WG], p->in[I_WU], DFF, 1024, 2 * DFF, p->Wgu0, 1, smem, rot);
      conv_wt(p->in[I_WG] + (size_t)1024 * DFF, p->in[I_WU] + (size_t)1024 * DFF, DFF, 1024, 2 * DFF, p->Wgu1, 1, smem, rot);
      conv_wt(p->in[I_WD], nullptr, 1024, DFF, 1024, p->Wdn0, 0, smem, rot);
      conv_wt(p->in[I_WD] + (size_t)DFF * 1024, nullptr, 1024, DFF, 1024, p->Wdn1, 0, smem, rot);
      conv_wt(p->in[I_W2], nullptr, 1024, 64, 1024, p->w2t, 0, smem, rot);
      conv_wt(p->in[I_A2], nullptr, 1024, 64, 1024, p->a2t, 0, smem, rot);
      conv_wt(p->in[I_G2], nullptr, 1024, 128, 1024, p->g2t, 0, smem, rot);
#pragma unroll 1
      for (int blk = 0; blk < 8; ++blk)
        conv_wt(p->in[I_LWR] + blk * 16384, p->in[I_LWI] + blk * 16384, 128, 128, 256, p->Wri + blk * 32768, 1, smem, rot);
      rmsnorm_phase(p->in[I_XP], p->in[I_XS], p->in[I_GMIX], p->H);
    } break;
    case 1: if (PH_ON(1)) {
      GemmArgs g{p->H, p->H, p->Win0t, 1024, 1024, 1 << 30, MROWS, LD0, 1024};
      gemm_run_big<3>(g, EpiBf16{p->PROJ, LD0, LD0}, smem, sc);
    } break;
    case 2: if (PH_ON(2)) prep0_phase(p); break;
    case 3: if (PH_ON(3)) {
      GemmArgs g0{p->L, p->L, p->w2t, 256, 256, 1 << 30, MROWS, 1024, 64};
      gemm_run(g0, EpiLora<0>{p->EW, p->in[I_W0]}, smem, sc);
      GemmArgs g1{p->L + 64, p->L + 64, p->a2t, 256, 256, 1 << 30, MROWS, 1024, 64};
      gemm_run(g1, EpiLora<1>{p->AA, p->in[I_A0]}, smem, sc, 8);
      GemmArgs g2{p->L + 128, p->L + 128, p->g2t, 256, 256, 1 << 30, MROWS, 1024, 128};
      gemm_run(g2, EpiLora<2>{p->GG, nullptr}, smem, sc, 16);
    } break;
    case 4: if (PH_ON(4)) {
      scan0_phase(p, smem); } break;
    case 5: if (PH_ON(5)) gla_norm_phase(p); break;
    case 6: if (PH_ON(6)) {
      GemmArgs g{p->PROJ + C_V, p->PROJ + C_R, p->Wout0t, LD0, LD0, 1024, MROWS, 1024, 2048};
      gemm_run_272(g, p->in[I_XP], p->in[I_XS], X, smem, sc);
    } break;
    case 7: if (PH_ON(7)) rmsnorm_phase(X, X + (size_t)RP * 1024, p->in[I_GFFN], p->H); break;
    case 8: if (PH_ON(8)) {
      GemmArgs g{p->H, p->H, p->Wgu0, 1024, 1024, 1 << 30, MROWS, 2 * DFF, 1024};
#ifdef GVAR
      gemm_run_big<GVAR>(g, EpiGateUp{p->PROJ}, smem, sc);
#endif
      gemm_run_big<3>(g, EpiGateUp{p->PROJ}, smem, sc);
    } break;
    case 9: if (PH_ON(9)) {
      GemmArgs g{p->PROJ, p->PROJ, p->Wdn0, DFF, DFF, 1 << 30, MROWS, 1024, DFF};
      gemm_run_272(g, X, X + (size_t)RP * 1024, X, smem, sc);
    } break;
    case 10: if (PH_ON(10)) rmsnorm_phase(X, X + (size_t)RP * 1024, p->in[I_GMIX] + 1024, p->H); break;
    case 11: if (PH_ON(11)) {
      GemmArgs g{p->H, p->H, p->Win1t, 1024, 1024, 1 << 30, MROWS, LD1, 1024};
      gemm_run_big<3>(g, EpiBf16{p->PROJ, LD1, LD1}, smem, sc);
    } break;
    case 12: if (PH_ON(12)) prep1_phase(p); break;
    case 13: if (PH_ON(13)) {
#pragma unroll 1
      for (int blk = 0; blk < 8; ++blk) {
        GemmArgs g{p->XC + blk * 128, p->XC + blk * 128, p->Wri + blk * 32768, 1024, 1024, 1 << 30, MROWS, 256, 128};
        gemm_run(g, EpiLruGate{p->PROJ, p->GX, p->XC, p->in[I_LBR], p->in[I_LBI], p->in[I_LAMBDA], blk}, smem, sc, blk * 34);
      }
    } break;
    case 14: if (PH_ON(14)) {
      scan1_phase(p, smem); } break;
    case 15: if (PH_ON(15)) ssd_norm_phase(p); break;
    case 16: if (PH_ON(16)) {
      GemmArgs g{p->PROJ + D_GATE, p->PROJ + D_Z, p->Wout1t, LD1, LD1, 1024, MROWS, 1024, 2048};
      gemm_run_272(g, X, X + (size_t)RP * 1024, X, smem, sc);
    } break;
    case 17: if (PH_ON(17)) rmsnorm_phase(X, X + (size_t)RP * 1024, p->in[I_GFFN] + 1024, p->H); break;
    case 18: if (PH_ON(18)) {
      GemmArgs g{p->H, p->H, p->Wgu1, 1024, 1024, 1 << 30, MROWS, 2 * DFF, 1024};
      gemm_run_big<3>(g, EpiGateUp{p->PROJ}, smem, sc);
    } break;
    case 19: if (PH_ON(19)) {
      GemmArgs g{p->PROJ, p->PROJ, p->Wdn1, DFF, DFF, 1 << 30, MROWS, 1024, DFF};
      gemm_run_272(g, X, X + (size_t)RP * 1024, X, smem, sc);
    } break;
    case 20: if (PH_ON(20)) final_norm_phase(X, p->in[I_GFINAL]); break;
    default: break;
  }
}

struct XB { unsigned* bar; unsigned x, nloc, nx, rank, xidx; };

template <int PH>
__device__ __forceinline__ void phase_step(char* smem, cg::grid_group& grid, XB& xb) {
  KP p = (KP)__builtin_amdgcn_kernarg_segment_ptr();
  asm volatile("" : "+s"(p));
  {
    Sched sc; sc.xidx = (int)xb.xidx; sc.nx = (int)xb.nx; sc.rank = (int)xb.rank; sc.nloc = (int)xb.nloc;
    run_phase<PH>(p, smem, sc);
  }
  if (PH == 0) {
    grid.sync();
    unsigned nloc = 1u, nx = 0u, xi = 0u;
#pragma unroll
    for (unsigned j = 0; j < 16; ++j) {
      const unsigned c = xb_ld(&xb.bar[XB_XCNT(j)]);
      nx += (c > 0u) ? 1u : 0u;
      xi += (c > 0u && j < xb.x) ? 1u : 0u;
      nloc = (j == xb.x) ? c : nloc;
    }
    xb.xidx = (unsigned)__builtin_amdgcn_readfirstlane((int)xi);
    xb.nloc = (unsigned)__builtin_amdgcn_readfirstlane((int)(nloc > 0u ? nloc : 1u));
    xb.nx = (unsigned)__builtin_amdgcn_readfirstlane((int)(nx > 0u ? nx : 1u));
  } else if (PH + 1 < N_PHASES) {
    xcd_barrier(xb.bar, xb.x, xb.nloc, xb.nx);
#ifdef EXTRA_SYNC
    xcd_barrier(xb.bar, xb.x, xb.nloc, xb.nx); xcd_barrier(xb.bar, xb.x, xb.nloc, xb.nx);
#endif
  }
}

__global__ void __launch_bounds__(256, 2) mk_forward(Params pdummy) {
  __shared__ __attribute__((aligned(16))) char smem[65536];
  cg::grid_group grid = cg::this_grid();
  XB xb;
  {
    KP p = (KP)__builtin_amdgcn_kernarg_segment_ptr();
    xb.bar = p->bar; xb.x = xb_xcc_id(); xb.nloc = 1u; xb.nx = 1u; xb.xidx = 0u;
    unsigned rk = 0u;
    if (threadIdx.x == 0) rk = xb_add(&xb.bar[XB_XCNT(xb.x)], 1u);
    xb.rank = (unsigned)__builtin_amdgcn_readfirstlane((int)rk);
    {
      unsigned* sh = (unsigned*)(smem + 65028);
      if (threadIdx.x == 0) *sh = rk;
      __syncthreads();
      xb.rank = (unsigned)__builtin_amdgcn_readfirstlane((int)*sh);
      __syncthreads();
    }
  }
  phase_step<0>(smem, grid, xb);   phase_step<1>(smem, grid, xb);   phase_step<2>(smem, grid, xb);
  phase_step<3>(smem, grid, xb);   phase_step<4>(smem, grid, xb);   phase_step<5>(smem, grid, xb);
  phase_step<6>(smem, grid, xb);   phase_step<7>(smem, grid, xb);   phase_step<8>(smem, grid, xb);
  phase_step<9>(smem, grid, xb);   phase_step<10>(smem, grid, xb);  phase_step<11>(smem, grid, xb);
  phase_step<12>(smem, grid, xb);  phase_step<13>(smem, grid, xb);  phase_step<14>(smem, grid, xb);
  phase_step<15>(smem, grid, xb);  phase_step<16>(smem, grid, xb);  phase_step<17>(smem, grid, xb);
  phase_step<18>(smem, grid, xb);  phase_step<19>(smem, grid, xb);  phase_step<20>(smem, grid, xb);
}

#ifndef MK_SPLIT
#define MK_SPLIT 0
#endif

extern "C" void kernel_launch(void* const* d_in, const int* in_sizes, int n_in, void* d_out, int out_size, void* d_ws,
                              size_t ws_size, hipStream_t stream) {
  static int grid_blocks = 0;
  if (!grid_blocks) {
    int dev = 0, cus = 0, per_cu = 0;
    hipGetDevice(&dev);
    hipDeviceGetAttribute(&cus, hipDeviceAttributeMultiprocessorCount, dev);
    hipOccupancyMaxActiveBlocksPerMultiprocessor(&per_cu, mk_forward, 256, 0);
    if (per_cu > 2) per_cu = 2;
    grid_blocks = cus * per_cu;
  }
  Params p{};
  for (int i = 0; i < N_IN; ++i) p.in[i] = (const float*)d_in[i];
  p.out = (float*)d_out;
  char* w = (char*)d_ws;
  size_t off = 0;
  auto take = [&](size_t bytes) { char* r = w + off; off += (bytes + 255) & ~(size_t)255; return r; };
  p.ctr = (unsigned*)take(256);
  p.bar = (unsigned*)take(XCD_BAR_WORDS * 4);
  p.Win0t = (bf16_t*)take((size_t)LD0 * 1024 * 2);
  p.Wout0t = (bf16_t*)take((size_t)1024 * 2048 * 2);
  p.Win1t = (bf16_t*)take((size_t)LD1 * 1024 * 2);
  p.Wout1t = (bf16_t*)take((size_t)1024 * 2048 * 2);
  p.Wgu0 = (bf16_t*)take((size_t)2 * DFF * 1024 * 2);
  p.Wgu1 = (bf16_t*)take((size_t)2 * DFF * 1024 * 2);
  p.Wdn0 = (bf16_t*)take((size_t)1024 * DFF * 2);
  p.Wdn1 = (bf16_t*)take((size_t)1024 * DFF * 2);
  p.w2t = (bf16_t*)take((size_t)1024 * 64 * 2);
  p.a2t = (bf16_t*)take((size_t)1024 * 64 * 2);
  p.g2t = (bf16_t*)take((size_t)1024 * 128 * 2);
  p.Wri = (bf16_t*)take((size_t)8 * 256 * 128 * 2);
  p.PROJ = (bf16_t*)take((size_t)MROWS * LD0 * 2);
  p.H = (bf16_t*)take((size_t)MROWS * 1024 * 2);
  p.GG = p.H;
  p.XC = p.H;
  const size_t off_extra = off;
  p.L = (bf16_t*)take((size_t)MROWS * 256 * 2);
  p.LA = (bf16_t*)take((size_t)MROWS * 512 * 2);
  size_t end0 = off;
  off = off_extra;
  p.GX = (bf16_t*)take((size_t)MROWS * 1024 * 2);
  p.DT = (float*)take((size_t)MROWS * 16 * 4);
  size_t end1 = off;
  p.XBC = p.PROJ + (size_t)MROWS * LD1 + 128;
  p.EW = (bf16_t*)((float*)d_out + O_SLRU);
  p.AA = p.EW + (size_t)MROWS * 1024;
  size_t need = end0 > end1 ? end0 : end1;
  if (need > ws_size || (size_t)out_size < O_END) {
    fprintf(stderr, "workspace too small: need %zu have %zu (out %d)\n", need, ws_size, out_size);
    return;
  }
  hipMemsetAsync(p.bar, 0, XCD_BAR_WORDS * 4, stream);
  p.ph_begin = 0; p.ph_end = N_PHASES;
#ifndef REP_LONG
#define REP_LONG 1
#endif
#ifndef REP_SHORT
#define REP_SHORT 1
#endif
  p.rep_long = REP_LONG; p.rep_short = REP_SHORT;
  void* args[] = {&p};
  hipError_t e = hipLaunchCooperativeKernel((void*)mk_forward, dim3(grid_blocks), dim3(256), args, 0, stream);
  if (e != hipSuccess) fprintf(stderr, "cooperative launch failed: %s (grid %d)\n", hipGetErrorString(e), grid_blocks);
}
```

```cpp
#include <hip/hip_runtime.h>
#include <hip/hip_cooperative_groups.h>
#include <cstdio>
namespace cg = cooperative_groups;

typedef unsigned short bf16_t;
typedef short bf16x8 __attribute__((ext_vector_type(8)));
typedef float f32x4 __attribute__((ext_vector_type(4)));

constexpr int DM = 1024;
constexpr int RP = 16384;
constexpr int MROWS = 17408;
constexpr int NSEQ = 136;
constexpr int LD0 = 6416, LD1 = 4624, DFF = 2816;
constexpr int C_Q = 0, C_K = 512, C_V = 1024, C_AL = 2048, C_OG = 2064;
constexpr int RW0 = 3088;
constexpr int C_R = RW0, C_KR = RW0 + 1024, C_VR = RW0 + 2048, C_LORA = RW0 + 3072;
constexpr int D_GATE = 0, D_XBR = 1024, D_Z = 2048, D_XBC = 3072, D_DT = 4608;

constexpr size_t O_Y = 0;
constexpr size_t O_PGLA = (size_t)MROWS * 1024;
constexpr size_t O_PRWKV = O_PGLA + 8ull * 4 * 128 * 256;
constexpr size_t O_PSHIFT = O_PRWKV + 8ull * 16 * 64 * 64;
constexpr size_t O_PLRU = O_PSHIFT + 8ull * 3328;
constexpr size_t O_PLRUC = O_PLRU + 8ull * 1024;
constexpr size_t O_PSSD = O_PLRUC + 8ull * 3 * 1024;
constexpr size_t O_PSSDC = O_PSSD + 8ull * 16 * 64 * 128;
constexpr size_t O_SGLA = O_PSSDC + 8ull * 3 * 1536;
constexpr size_t O_SRWKV = O_SGLA + 128ull * 4 * 128 * 256;
constexpr size_t O_SSHIFT = O_SRWKV + 128ull * 16 * 64 * 64;
constexpr size_t O_SLRU = O_SSHIFT + 128ull * 3328;
constexpr size_t O_SLRUC = O_SLRU + 128ull * 1024;
constexpr size_t O_SSSD = O_SLRUC + 128ull * 3 * 1024;
constexpr size_t O_SSSDC = O_SSSD + 128ull * 16 * 64 * 128;
constexpr size_t O_END = O_SSSDC + 128ull * 3 * 1536;

enum {
  I_XP = 0, I_XS, I_SGLA, I_SRWKV, I_SSHIFT, I_SLRU, I_SLRUC, I_SSSD, I_SSSDC,
  I_WIN0, I_GLA_WA2, I_GLA_BA, I_GLA_GN, I_MU, I_W0, I_W2, I_A0, I_A2, I_G2, I_KK, I_KA, I_RK, I_LNW, I_LNB, I_WOUT0,
  I_WIN1, I_LCW, I_LCB, I_LWR, I_LBR, I_LWI, I_LBI, I_LAMBDA, I_SCW, I_SCB, I_DTB, I_ALOG, I_SD, I_SNW, I_WOUT1,
  I_GMIX, I_GFFN, I_WG, I_WU, I_WD, I_GFINAL, N_IN
};

struct Params {
  const float* in[N_IN];
  float* out;
  bf16_t *Win0t, *Wout0t, *Win1t, *Wout1t, *Wgu0, *Wgu1, *Wdn0, *Wdn1, *w2t, *a2t, *g2t, *Wri;
  bf16_t *H, *PROJ, *L, *LA, *GG, *EW, *AA, *XC, *XBC, *GX;
  float* DT;
  unsigned* ctr;
  unsigned* bar;
  int ph_begin, ph_end;
  int rep_long, rep_short;
};

typedef const Params __attribute__((address_space(4)))* KP;

__device__ __forceinline__ float bf2f(bf16_t v) { return __uint_as_float(((unsigned)v) << 16); }
__device__ __forceinline__ bf16_t f2bf(float f) {
  unsigned u = __float_as_uint(f);
  u += 0x7fffu + ((u >> 16) & 1u);
  return (bf16_t)(u >> 16);
}
__device__ __forceinline__ float bf2f(unsigned v) { return __uint_as_float(v << 16); }
__device__ __forceinline__ unsigned pack2(float a, float b) { return (unsigned)f2bf(a) | ((unsigned)f2bf(b) << 16); }
__device__ __forceinline__ float lo16(unsigned u) { return __uint_as_float(u << 16); }
__device__ __forceinline__ float hi16(unsigned u) { return __uint_as_float(u & 0xffff0000u); }
__device__ __forceinline__ float sigmoidf_(float x) { return 1.f / (1.f + __expf(-x)); }
__device__ __forceinline__ float softplusf_(float x) { return fmaxf(x, 0.f) + log1pf(__expf(-fabsf(x))); }
__device__ __forceinline__ float siluf_(float x) { return x * sigmoidf_(x); }
__device__ __forceinline__ float geluf_(float x) {
  float u = 0.7978845608028654f * (x + 0.044715f * x * x * x);
  return 0.5f * x * (1.f + tanhf(u));
}
__device__ __forceinline__ float wave_sum(float v) {
  v += __shfl_xor(v, 32); v += __shfl_xor(v, 16); v += __shfl_xor(v, 8);
  v += __shfl_xor(v, 4); v += __shfl_xor(v, 2); v += __shfl_xor(v, 1);
  return v;
}

struct Seq { int row0, T, b, sample; };
__device__ __forceinline__ Seq get_seq(int s) {
  Seq q;
  if (s < 8) { q.row0 = s * 2048; q.T = 2048; q.b = s; q.sample = 0; }
  else { q.b = s - 8; q.row0 = RP + q.b * 8; q.T = 8; q.sample = 1; }
  return q;
}

struct Sched { int xidx, nx, rank, nloc; };
struct GemmArgs { const bf16_t* A1; const bf16_t* A2; const bf16_t* Bt; int lda1, lda2, ksplit, M, N, K; };

template <class Epi>
__device__ __forceinline__ void gemm_run(const GemmArgs g, const Epi epi, char* smem, const Sched sc, int rot = 0) {
  const int tid = threadIdx.x, lane = tid & 63, wid = tid >> 6;
  const int wm = wid >> 1, wn = wid & 1, fr = lane & 15, fq = lane >> 4;
  const int ntn = (g.N + 127) >> 7, nt = (g.M >> 7) * ntn, nk = g.K >> 6;
  const int lr = tid >> 3, lc = tid & 7;
  bf16_t* sbase = (bf16_t*)smem;
  const int ntm = g.M >> 7;
  const int cq = nt / sc.nx, cr = nt - cq * sc.nx;
  const int cnt = sc.xidx < cr ? cq + 1 : cq;
  const int cstart = sc.xidx < cr ? sc.xidx * (cq + 1) : cr * (cq + 1) + (sc.xidx - cr) * cq;
  const int rk = (sc.rank + rot) % sc.nloc;
  int nfull = cnt, rem = 0, S = 1;
  if (Epi::SPLITK) {
    const int r_ = cnt % sc.nloc;
    if (r_ > 0 && 2 * r_ <= sc.nloc) { rem = r_; nfull = cnt - r_; S = min(sc.nloc / r_, nk); }
  }
  const int nitems = (nfull - rk + sc.nloc - 1) / sc.nloc + ((rem > 0 && rk < rem * S) ? 1 : 0);
  for (int it = 0; it < nitems; ++it) {
    int qi = rk + it * sc.nloc, k0 = 0, k1 = nk;
    bool split = false;
    if (qi >= nfull) { qi = nfull + rk / S; const int part = rk - (rk / S) * S; k0 = part * nk / S; k1 = (part + 1) * nk / S; split = true; }
    const int L = cstart + qi;
    const int nig = 8 * ntn, gid = L / nig, fm = gid * 8, gsz = min(ntm - fm, 8), wi = L - gid * nig;
    const int tm = fm + wi % gsz, tn = wi / gsz;
    f32x4 acc[4][4];
#pragma unroll
    for (int mi = 0; mi < 4; ++mi)
#pragma unroll
      for (int ni = 0; ni < 4; ++ni) acc[mi][ni] = (f32x4){0.f, 0.f, 0.f, 0.f};
    uint4 ra00, ra01, ra02, ra03, rb00, rb01, rb02, rb03, ra10, ra11, ra12, ra13, rb10, rb11, rb12, rb13;
#define GL1(KT, RA, RB, P)                                                                          \
      { const int r_ = lr + 32 * (P);                                                               \
        RA = *(const uint4*)(Ab_ + (size_t)(tm * 128 + r_) * lda_ + kk_ + lc * 8);                  \
        int n_ = tn * 128 + r_; n_ = n_ < g.N ? n_ : g.N - 1;                                       \
        RB = *(const uint4*)(g.Bt + (size_t)n_ * g.K + ((KT) << 6) + lc * 8); }
#define GLOAD(KT, S)                                                                                \
    {                                                                                               \
      int kk_ = (KT) << 6; const bf16_t* Ab_ = g.A1; int lda_ = g.lda1;                             \
      if (kk_ >= g.ksplit) { Ab_ = g.A2; lda_ = g.lda2; kk_ -= g.ksplit; }                          \
      GL1(KT, ra##S##0, rb##S##0, 0) GL1(KT, ra##S##1, rb##S##1, 1)                                 \
      GL1(KT, ra##S##2, rb##S##2, 2) GL1(KT, ra##S##3, rb##S##3, 3)                                 \
    }
#define SS1(RA, RB, P)                                                                              \
      { const int r_ = lr + 32 * (P);                                                               \
        const int off_ = r_ * 64 + ((lc ^ ((r_ >> 1) & 7)) << 3);                                   \
        *(uint4*)(sa_ + off_) = RA; *(uint4*)(sb_ + off_) = RB; }
#define SSTORE(BUF, S)                                                                              \
    {                                                                                               \
      bf16_t* sa_ = sbase + (BUF) * 16384; bf16_t* sb_ = sa_ + 8192;                                \
      SS1(ra##S##0, rb##S##0, 0) SS1(ra##S##1, rb##S##1, 1) SS1(ra##S##2, rb##S##2, 2) SS1(ra##S##3, rb##S##3, 3) \
    }
#define COMPUTE(BUF)                                                                                \
    {                                                                                               \
      const bf16_t* sa = sbase + (BUF) * 16384; const bf16_t* sb = sa + 8192;                       \
      _Pragma("unroll") for (int ks = 0; ks < 2; ++ks) {                                            \
        bf16x8 af[4], bfr[4];                                                                       \
        const int ch = ks * 4 + fq;                                                                 \
        _Pragma("unroll") for (int mi = 0; mi < 4; ++mi) {                                          \
          const int r = wm * 64 + mi * 16 + fr;                                                     \
          af[mi] = *(const bf16x8*)(sa + r * 64 + ((ch ^ ((r >> 1) & 7)) << 3));                    \
        }                                                                                           \
        _Pragma("unroll") for (int ni = 0; ni < 4; ++ni) {                                          \
          const int r = wn * 64 + ni * 16 + fr;                                                     \
          bfr[ni] = *(const bf16x8*)(sb + r * 64 + ((ch ^ ((r >> 1) & 7)) << 3));                   \
        }                                                                                           \
        _Pragma("unroll") for (int mi = 0; mi < 4; ++mi)                                            \
          _Pragma("unroll") for (int ni = 0; ni < 4; ++ni)                                          \
            acc[mi][ni] = __builtin_amdgcn_mfma_f32_16x16x32_bf16(bfr[ni], af[mi], acc[mi][ni], 0, 0, 0); \
      }                                                                                             \
    }
    __syncthreads();
    GLOAD(k0, 0);
    GLOAD(min(k0 + 1, k1 - 1), 1);
    SSTORE(0, 0);
    __syncthreads();
    int kt = k0;
    for (; kt + 1 < k1; kt += 2) {
      GLOAD(min(kt + 2, k1 - 1), 0);
      COMPUTE(0);
      SSTORE(1, 1);
      __syncthreads();
      GLOAD(min(kt + 3, k1 - 1), 1);
      COMPUTE(1);
      if (kt + 2 < k1) SSTORE(0, 0);
      __syncthreads();
    }
    if (kt < k1) { COMPUTE(0); __syncthreads(); }
#undef GLOAD
#undef SSTORE
#undef COMPUTE
#undef GL1
#undef SS1
    epi(acc, tm * 128 + wm * 64, tn * 128 + wn * 64, fr, fq, split);
  }
}

template <int VAR, class Epi>
__device__ __forceinline__ void gemm_run_big(const GemmArgs g, const Epi epi, char* smem, const Sched sc) {
  const int tid = threadIdx.x, lane = tid & 63, wid = tid >> 6;
  const int wm = wid >> 1, wn = wid & 1, fr = lane & 15, fq = lane >> 4;
  const int ntn = (g.N + 127) >> 7, ntm = g.M >> 8, nt = ntm * ntn, nk = g.K >> 5;
  const int lr = tid >> 2, lc = tid & 3;
  bf16_t* sbase = (bf16_t*)smem;
  const int cq = nt / sc.nx, cr = nt - cq * sc.nx;
  const int cnt = sc.xidx < cr ? cq + 1 : cq;
  const int cstart = sc.xidx < cr ? sc.xidx * (cq + 1) : cr * (cq + 1) + (sc.xidx - cr) * cq;
  for (int qi = sc.rank; qi < cnt; qi += sc.nloc) {
    const int L = cstart + qi;
    const int nig = 8 * ntn, gid = L / nig, fm = gid * 8, gsz = min(ntm - fm, 8), wi = L - gid * nig;
    const int tm = fm + wi % gsz, tn = wi / gsz;
    f32x4 acc[8][4];
#pragma unroll
    for (int mi = 0; mi < 8; ++mi)
#pragma unroll
      for (int ni = 0; ni < 4; ++ni) acc[mi][ni] = (f32x4){0.f, 0.f, 0.f, 0.f};
    uint4 a00, a01, a02, a03, b00, b01, a10, a11, a12, a13, b10, b11;
    const bf16_t* Ap = g.A1 + (size_t)(tm * 256 + lr) * g.lda1 + lc * 8;
    int nb0 = tn * 128 + lr, nb1 = nb0 + 64;
    nb0 = nb0 < g.N ? nb0 : g.N - 1; nb1 = nb1 < g.N ? nb1 : g.N - 1;
    const bf16_t* Bp0 = g.Bt + (size_t)nb0 * g.K + lc * 8;
    const bf16_t* Bp1 = g.Bt + (size_t)nb1 * g.K + lc * 8;
    const size_t a64 = (size_t)64 * g.lda1;
#define BGLOAD(KT, S)                                                                          \
    { const int ko_ = (VAR == 1) ? 0 : ((KT) << 5);                                            \
      a##S##0 = *(const uint4*)(Ap + ko_);           a##S##1 = *(const uint4*)(Ap + a64 + ko_); \
      a##S##2 = *(const uint4*)(Ap + 2 * a64 + ko_); a##S##3 = *(const uint4*)(Ap + 3 * a64 + ko_); \
      b##S##0 = *(const uint4*)(Bp0 + ko_);          b##S##1 = *(const uint4*)(Bp1 + ko_); }
    const int soff = lr * 32 + ((lc ^ ((lr >> 2) & 3)) << 3);
#define BSSTORE(BUF, S)                                                                        \
    { bf16_t* sa_ = sbase + (BUF) * 12288; bf16_t* sb_ = sa_ + 8192;                           \
      *(uint4*)(sa_ + soff) = a##S##0;        *(uint4*)(sa_ + soff + 2048) = a##S##1;          \
      *(uint4*)(sa_ + soff + 4096) = a##S##2; *(uint4*)(sa_ + soff + 6144) = a##S##3;          \
      *(uint4*)(sb_ + soff) = b##S##0;        *(uint4*)(sb_ + soff + 2048) = b##S##1; }
#define BCOMPUTE(BUF)                                                                          \
    { const bf16_t* sa = sbase + (BUF) * 12288; const bf16_t* sb = sa + 8192;                  \
      bf16x8 bfr[4];                                                                           \
      _Pragma("unroll") for (int ni = 0; ni < 4; ++ni) {                                       \
        const int r = wn * 64 + ni * 16 + fr;                                                  \
        bfr[ni] = *(const bf16x8*)(sb + r * 32 + ((fq ^ ((r >> 2) & 3)) << 3));                \
      }                                                                                        \
      _Pragma("unroll") for (int mi = 0; mi < 8; ++mi) {                                       \
        const int r = wm * 128 + mi * 16 + fr;                                                 \
        const bf16x8 af = *(const bf16x8*)(sa + r * 32 + ((fq ^ ((r >> 2) & 3)) << 3));        \
        _Pragma("unroll") for (int ni = 0; ni < 4; ++ni)                                       \
          acc[mi][ni] = __builtin_amdgcn_mfma_f32_16x16x32_bf16(bfr[ni], af, acc[mi][ni], 0, 0, 0); \
      }                                                                                        \
    }
    if (VAR == 3) {
      const int csw = lc ^ ((lr >> 2) & 3);
      const bf16_t* Aq = g.A1 + (size_t)(tm * 256 + lr) * g.lda1 + csw * 8;
      const bf16_t* Bq0 = g.Bt + (size_t)nb0 * g.K + csw * 8;
      const bf16_t* Bq1 = g.Bt + (size_t)nb1 * g.K + csw * 8;
      const int loff = lr * 32 + lc * 8;
#define BGLDS(KT, BUF)                                                                                     \
      { const int ko_ = (KT) << 5; bf16_t* sa_ = sbase + (BUF) * 12288; bf16_t* sb_ = sa_ + 8192;              \
        __builtin_amdgcn_global_load_lds((const unsigned*)(Aq + ko_), (unsigned*)(sa_ + loff), 16, 0, 0);            \
        __builtin_amdgcn_global_load_lds((const unsigned*)(Aq + a64 + ko_), (unsigned*)(sa_ + loff + 2048), 16, 0, 0); \
        __builtin_amdgcn_global_load_lds((const unsigned*)(Aq + 2 * a64 + ko_), (unsigned*)(sa_ + loff + 4096), 16, 0, 0); \
        __builtin_amdgcn_global_load_lds((const unsigned*)(Aq + 3 * a64 + ko_), (unsigned*)(sa_ + loff + 6144), 16, 0, 0); \
        __builtin_amdgcn_global_load_lds((const unsigned*)(Bq0 + ko_), (unsigned*)(sb_ + loff), 16, 0, 0);           \
        __builtin_amdgcn_global_load_lds((const unsigned*)(Bq1 + ko_), (unsigned*)(sb_ + loff + 2048), 16, 0, 0); }
      __syncthreads();
      BGLDS(0, 0);
#pragma unroll 1
      for (int kt = 0; kt < nk; kt += 2) {
        asm volatile("s_waitcnt vmcnt(0)" ::: "memory");
        __syncthreads();
        if (kt + 1 < nk) BGLDS(kt + 1, 1);
        BCOMPUTE(0);
        if (kt + 1 < nk) {
          asm volatile("s_waitcnt vmcnt(0)" ::: "memory");
          __syncthreads();
          if (kt + 2 < nk) BGLDS(kt + 2, 0);
          BCOMPUTE(1);
        }
      }
      __syncthreads();
#undef BGLDS
    } else {
    __syncthreads();
    BGLOAD(0, 0);
    BGLOAD(min(1, nk - 1), 1);
    BSSTORE(0, 0);
    __syncthreads();
    int kt = 0;
    for (; kt + 1 < nk; kt += 2) {
      BGLOAD(min(kt + 2, nk - 1), 0);
      BCOMPUTE(0);
      if (VAR != 2) BSSTORE(1, 1);
      __syncthreads();
      BGLOAD(min(kt + 3, nk - 1), 1);
      BCOMPUTE(1);
      if (VAR != 2 && kt + 2 < nk) BSSTORE(0, 0);
      __syncthreads();
    }
    if (kt < nk) { BCOMPUTE(0); __syncthreads(); }
    if (VAR == 2 && g.M < 0) { BSSTORE(0, 0); BSSTORE(1, 1); }
    }
#undef BGLOAD
#undef BSSTORE
#undef BCOMPUTE
    epi(acc, tm * 256 + wm * 128, tn * 128 + wn * 64, fr, fq, false);
  }
}

__device__ __forceinline__ void gemm_run_272(const GemmArgs g, const float* srcA, const float* srcB, float* dst, char* smem, const Sched sc) {
  const int tid = threadIdx.x, lane = tid & 63, wid = tid >> 6;
  const int wm = wid >> 1, wn = wid & 1, fr = lane & 15, fq = lane >> 4;
  const int ntn = g.N >> 7, ntm = g.M / 272, nt = ntm * ntn, nk = g.K >> 5;
  const int lr = tid >> 2, lc = tid & 3;
  bf16_t* sbase = (bf16_t*)smem;
  const int cq = nt / sc.nx, cr = nt - cq * sc.nx;
  const int cnt = sc.xidx < cr ? cq + 1 : cq;
  const int cstart = sc.xidx < cr ? sc.xidx * (cq + 1) : cr * (cq + 1) + (sc.xidx - cr) * cq;
  const int mrow0 = wm * 144;
  for (int qi = sc.rank; qi < cnt; qi += sc.nloc) {
    const int L = cstart + qi;
    const int nig = 8 * ntn, gid = L / nig, fm = gid * 8, gsz = min(ntm - fm, 8), wi = L - gid * nig;
    const int tm = fm + wi % gsz, tn = wi / gsz;
    f32x4 acc[9][4];
#pragma unroll
    for (int mi = 0; mi < 9; ++mi)
#pragma unroll
      for (int ni = 0; ni < 4; ++ni) acc[mi][ni] = (f32x4){0.f, 0.f, 0.f, 0.f};
    const int csw = lc ^ ((lr >> 2) & 3);
    const size_t arow = (size_t)(tm * 272 + lr);
    const bf16_t* Bq0 = g.Bt + (size_t)(tn * 128 + lr) * g.K + csw * 8;
    const bf16_t* Bq1 = Bq0 + (size_t)64 * g.K;
    const int loff = lr * 32 + lc * 8;
#define NGLDS(KT, BUF)                                                                                         \
    { int kk_ = (KT) << 5; const bf16_t* Ab_ = g.A1; int lda_ = g.lda1;                                        \
      if (kk_ >= g.ksplit) { Ab_ = g.A2; lda_ = g.lda2; kk_ -= g.ksplit; }                                     \
      const bf16_t* Aq_ = Ab_ + arow * lda_ + csw * 8 + kk_; const size_t a64_ = (size_t)64 * lda_;            \
      bf16_t* sa_ = sbase + (BUF) * 12800; bf16_t* sb_ = sa_ + 8704;                                           \
      __builtin_amdgcn_global_load_lds((const unsigned*)(Aq_), (unsigned*)(sa_ + loff), 16, 0, 0);             \
      __builtin_amdgcn_global_load_lds((const unsigned*)(Aq_ + a64_), (unsigned*)(sa_ + loff + 2048), 16, 0, 0);     \
      __builtin_amdgcn_global_load_lds((const unsigned*)(Aq_ + 2 * a64_), (unsigned*)(sa_ + loff + 4096), 16, 0, 0); \
      __builtin_amdgcn_global_load_lds((const unsigned*)(Aq_ + 3 * a64_), (unsigned*)(sa_ + loff + 6144), 16, 0, 0); \
      if (wid == 0) __builtin_amdgcn_global_load_lds((const unsigned*)(Aq_ + 4 * a64_), (unsigned*)(sa_ + loff + 8192), 16, 0, 0); \
      __builtin_amdgcn_global_load_lds((const unsigned*)(Bq0 + ((KT) << 5)), (unsigned*)(sb_ + loff), 16, 0, 0);     \
      __builtin_amdgcn_global_load_lds((const unsigned*)(Bq1 + ((KT) << 5)), (unsigned*)(sb_ + loff + 2048), 16, 0, 0); }
#define NCOMPUTE(BUF)                                                                          \
    { const bf16_t* sa = sbase + (BUF) * 12800; const bf16_t* sb = sa + 8704;                  \
      bf16x8 bfr[4];                                                                           \
      _Pragma("unroll") for (int ni = 0; ni < 4; ++ni) {                                       \
        const int r = wn * 64 + ni * 16 + fr;                                                  \
        bfr[ni] = *(const bf16x8*)(sb + r * 32 + ((fq ^ ((r >> 2) & 3)) << 3));                \
      }                                                                                        \
      _Pragma("unroll") for (int mi = 0; mi < 9; ++mi) {                                       \
        if (mi < 8 || wm == 0) {                                                               \
          const int r = mrow0 + mi * 16 + fr;                                                  \
          const bf16x8 af = *(const bf16x8*)(sa + r * 32 + ((fq ^ ((r >> 2) & 3)) << 3));      \
          _Pragma("unroll") for (int ni = 0; ni < 4; ++ni)                                     \
            acc[mi][ni] = __builtin_amdgcn_mfma_f32_16x16x32_bf16(bfr[ni], af, acc[mi][ni], 0, 0, 0); \
        }                                                                                      \
      }                                                                                        \
    }
    __syncthreads();
    NGLDS(0, 0);
#pragma unroll 1
    for (int kt = 0; kt < nk; kt += 2) {
      asm volatile("s_waitcnt vmcnt(0)" ::: "memory");
      __syncthreads();
      if (kt + 1 < nk) NGLDS(kt + 1, 1);
      NCOMPUTE(0);
      if (kt + 1 < nk) {
        asm volatile("s_waitcnt vmcnt(0)" ::: "memory");
        __syncthreads();
        if (kt + 2 < nk) NGLDS(kt + 2, 0);
        NCOMPUTE(1);
      }
    }
    __syncthreads();
#undef NGLDS
#undef NCOMPUTE
    const int rb = tm * 272 + mrow0, cb = tn * 128 + wn * 64;
#pragma unroll
    for (int mi = 0; mi < 9; ++mi) {
      if (mi < 8 || wm == 0) {
        const int row = rb + mi * 16 + fr;
        const float* sp = row < RP ? srcA + (size_t)row * 1024 : srcB + (size_t)(row - RP) * 1024;
#pragma unroll
        for (int ni = 0; ni < 4; ++ni) {
          const int col = cb + ni * 16 + fq * 4;
          float4 x = *(const float4*)(sp + col);
          float4 o; o.x = x.x + acc[mi][ni][0]; o.y = x.y + acc[mi][ni][1]; o.z = x.z + acc[mi][ni][2]; o.w = x.w + acc[mi][ni][3];
          *(float4*)(dst + (size_t)row * 1024 + col) = o;
        }
      }
    }
  }
}

struct EpiBf16 {
  static constexpr bool SPLITK = false;
  bf16_t* O; int ld, N;
  template <int MI>
  __device__ __forceinline__ void operator()(f32x4 (&acc)[MI][4], int rb, int cb, int fr, int fq, bool) const {
#pragma unroll
    for (int mi = 0; mi < MI; ++mi) {
      const size_t row = rb + mi * 16 + fr;
#pragma unroll
      for (int ni = 0; ni < 4; ++ni) {
        const int col = cb + ni * 16 + fq * 4;
        if (col < N) {
          uint2 v; v.x = pack2(acc[mi][ni][0], acc[mi][ni][1]); v.y = pack2(acc[mi][ni][2], acc[mi][ni][3]);
          *(uint2*)(O + row * ld + col) = v;
        }
      }
    }
  }
};
template <bool SK>
struct EpiResidualT {
  static constexpr bool SPLITK = SK;
  const float* srcA; const float* srcB; float* dst;
  __device__ __forceinline__ void operator()(f32x4 (&acc)[4][4], int rb, int cb, int fr, int fq, bool split) const {
#pragma unroll
    for (int mi = 0; mi < 4; ++mi) {
      const int row = rb + mi * 16 + fr;
      const float* s = row < RP ? srcA + (size_t)row * 1024 : srcB + (size_t)(row - RP) * 1024;
#pragma unroll
      for (int ni = 0; ni < 4; ++ni) {
        const int col = cb + ni * 16 + fq * 4;
        float* d = dst + (size_t)row * 1024 + col;
        if (SK && split) {
          unsafeAtomicAdd(d + 0, acc[mi][ni][0]); unsafeAtomicAdd(d + 1, acc[mi][ni][1]);
          unsafeAtomicAdd(d + 2, acc[mi][ni][2]); unsafeAtomicAdd(d + 3, acc[mi][ni][3]);
        } else {
          float4 x = *(const float4*)(s + col);
          float4 o; o.x = x.x + acc[mi][ni][0]; o.y = x.y + acc[mi][ni][1]; o.z = x.z + acc[mi][ni][2]; o.w = x.w + acc[mi][ni][3];
          *(float4*)d = o;
        }
      }
    }
  }
};
typedef EpiResidualT<false> EpiResidual;
typedef EpiResidualT<true> EpiResidualSK;
struct EpiGateUp {
  static constexpr bool SPLITK = false;
  bf16_t* act;
  template <int MI>
  __device__ __forceinline__ void operator()(f32x4 (&acc)[MI][4], int rb, int cb, int fr, int fq, bool) const {
#pragma unroll
    for (int mi = 0; mi < MI; ++mi) {
      const size_t row = rb + mi * 16 + fr;
#pragma unroll
      for (int np = 0; np < 2; ++np) {
        const int c = ((cb + np * 32) >> 1) + fq * 4;
        float o[4];
#pragma unroll
        for (int j = 0; j < 4; ++j) o[j] = siluf_(acc[mi][2 * np][j]) * acc[mi][2 * np + 1][j];
        uint2 v; v.x = pack2(o[0], o[1]); v.y = pack2(o[2], o[3]);
        *(uint2*)(act + row * DFF + c) = v;
      }
    }
  }
};
template <int MODE>
struct EpiLora {
  static constexpr bool SPLITK = false;
  bf16_t* O; const float* bias;
  __device__ __forceinline__ void operator()(f32x4 (&acc)[4][4], int rb, int cb, int fr, int fq, bool) const {
#pragma unroll
    for (int mi = 0; mi < 4; ++mi) {
      const size_t row = rb + mi * 16 + fr;
#pragma unroll
      for (int ni = 0; ni < 4; ++ni) {
        const int col = cb + ni * 16 + fq * 4;
        float o[4];
#pragma unroll
        for (int j = 0; j < 4; ++j) {
          float a = acc[mi][ni][j];
          if (MODE == 0) { float x = bias[col + j] + a; o[j] = __expf(-softplusf_(-x) - 0.5f); }
          else if (MODE == 1) { o[j] = sigmoidf_(bias[col + j] + a); }
          else o[j] = a;
        }
        uint2 v; v.x = pack2(o[0], o[1]); v.y = pack2(o[2], o[3]);
        *(uint2*)(O + row * 1024 + col) = v;
      }
    }
  }
};
struct EpiLruGate {
  static constexpr bool SPLITK = false;
  bf16_t* PROJ; bf16_t* GX; const bf16_t* XC; const float* b_r; const float* b_i; const float* lam; int blk;
  __device__ __forceinline__ void operator()(f32x4 (&acc)[4][4], int rb, int cb, int fr, int fq, bool) const {
#pragma unroll
    for (int mi = 0; mi < 4; ++mi) {
      const size_t row = rb + mi * 16 + fr;
#pragma unroll
      for (int np = 0; np < 2; ++np) {
        const int e = blk * 128 + ((cb + np * 32) >> 1) + fq * 4;
        uint2 xu = *(const uint2*)(XC + row * 1024 + e);
        float xv[4] = {lo16(xu.x), hi16(xu.x), lo16(xu.y), hi16(xu.y)};
        float la[4], gx[4];
#pragma unroll
        for (int j = 0; j < 4; ++j) {
          float rg = sigmoidf_(acc[mi][2 * np][j] + b_r[e + j]);
          float ig = sigmoidf_(acc[mi][2 * np + 1][j] + b_i[e + j]);
          la[j] = -8.f * rg * softplusf_(-lam[e + j]);
          gx[j] = ig * xv[j];
        }
        uint2 v; v.x = pack2(la[0], la[1]); v.y = pack2(la[2], la[3]);
        *(uint2*)(PROJ + row * LD1 + D_XBR + e) = v;
        uint2 w; w.x = pack2(gx[0], gx[1]); w.y = pack2(gx[2], gx[3]);
        *(uint2*)(GX + row * 1024 + e) = w;
      }
    }
  }
};

__device__ void conv_wt(const float* src, const float* src2, int ld, int K, int Nout, bf16_t* dst, int paired,
                        char* smem, int& rot) {
  float* tile = (float*)smem;
  const int tid = threadIdx.x;
  const int ntk = K >> 6, ntn = (Nout + 63) >> 6, nt = ntk * ntn;
  const int G = (int)gridDim.x;
  const int start = (int)((blockIdx.x + G - (rot % G)) % G);
  rot += nt;
  for (int t = start; t < nt; t += G) {
    const int tk = t % ntk, tn = t / ntk;
    __syncthreads();
    {
      const int n = tn * 64 + (tid & 63);
      const float* s = src; int c = n;
      if (paired) { const int grp = n >> 5, w = n & 31; c = grp * 16 + (w & 15); s = (w < 16) ? src : src2; }
      const bool ok = n < Nout;
#pragma unroll
      for (int i = 0; i < 16; ++i) {
        const int k = (tid >> 6) + 4 * i;
        tile[k * 65 + (tid & 63)] = ok ? s[(size_t)(tk * 64 + k) * ld + c] : 0.f;
      }
    }
    __syncthreads();
    {
      const int n2 = tid >> 2, kc = (tid & 3) * 16;
      if (tn * 64 + n2 < Nout) {
        unsigned pk[8];
#pragma unroll
        for (int j = 0; j < 8; ++j) pk[j] = pack2(tile[(kc + 2 * j) * 65 + n2], tile[(kc + 2 * j + 1) * 65 + n2]);
        uint4* d = (uint4*)(dst + (size_t)(tn * 64 + n2) * K + tk * 64 + kc);
        d[0] = make_uint4(pk[0], pk[1], pk[2], pk[3]);
        d[1] = make_uint4(pk[4], pk[5], pk[6], pk[7]);
      }
    }
  }
}

__device__ void rmsnorm_phase(const float* xa, const float* xb, const float* g, bf16_t* H) {
  const int lane = threadIdx.x & 63, wid = threadIdx.x >> 6;
  const int nw = gridDim.x * 4;
  for (int row = blockIdx.x * 4 + wid; row < MROWS; row += nw) {
    const float* x = row < RP ? xa + (size_t)row * 1024 : xb + (size_t)(row - RP) * 1024;
    float4 v[4]; float ss = 0.f;
#pragma unroll
    for (int i = 0; i < 4; ++i) {
      v[i] = *(const float4*)(x + lane * 4 + 256 * i);
      ss += v[i].x * v[i].x + v[i].y * v[i].y + v[i].z * v[i].z + v[i].w * v[i].w;
    }
    ss = wave_sum(ss);
    const float rs = rsqrtf(ss * (1.f / 1024.f) + 1e-6f);
#pragma unroll
    for (int i = 0; i < 4; ++i) {
      const int c = lane * 4 + 256 * i;
      float4 gg = *(const float4*)(g + c);
      uint2 o; o.x = pack2(v[i].x * rs * gg.x, v[i].y * rs * gg.y); o.y = pack2(v[i].z * rs * gg.z, v[i].w * rs * gg.w);
      *(uint2*)(H + (size_t)row * 1024 + c) = o;
    }
  }
}
__device__ void final_norm_phase(float* x, const float* g) {
  const int lane = threadIdx.x & 63, wid = threadIdx.x >> 6;
  const int nw = gridDim.x * 4;
  for (int row = blockIdx.x * 4 + wid; row < MROWS; row += nw) {
    float* xr = x + (size_t)row * 1024;
    float4 v[4]; float ss = 0.f;
#pragma unroll
    for (int i = 0; i < 4; ++i) {
      v[i] = *(const float4*)(xr + lane * 4 + 256 * i);
      ss += v[i].x * v[i].x + v[i].y * v[i].y + v[i].z * v[i].z + v[i].w * v[i].w;
    }
    ss = wave_sum(ss);
    const float rs = rsqrtf(ss * (1.f / 1024.f) + 1e-6f);
#pragma unroll
    for (int i = 0; i < 4; ++i) {
      const int c = lane * 4 + 256 * i;
      float4 gg = *(const float4*)(g + c);
      float4 o; o.x = v[i].x * rs * gg.x; o.y = v[i].y * rs * gg.y; o.z = v[i].z * rs * gg.z; o.w = v[i].w * rs * gg.w;
      *(float4*)(xr + c) = o;
    }
  }
}

__device__ void prep0_phase(KP p) {
  const int tid = threadIdx.x;
  const int G = (int)gridDim.x;
  const float* mu = p->in[I_MU];
  const float* wa2 = p->in[I_GLA_WA2];
  const float* ba = p->in[I_GLA_BA];
  for (int row = blockIdx.x; row < MROWS; row += G) {
    int t, b, sample;
    if (row < RP) { t = row & 2047; b = row >> 11; sample = 0; } else { const int rr = row - RP; b = rr >> 3; t = rr & 7; sample = 1; }
    const bf16_t* pr = p->PROJ + (size_t)row * LD0;
    {
      const int j = tid;
      const float c = bf2f(pr[C_LORA + j]);
      float prev = 0.f;
      if (t > 0) prev = bf2f(pr[C_LORA + j - LD0]);
      else if (sample) prev = p->in[I_SSHIFT][(size_t)b * 3328 + 3072 + j];
      const float m = c + (prev - c) * mu[3072 + j];
      float val = m;
      if (j < 64) val = tanhf(m); else if (j >= 128) val = sigmoidf_(m);
      p->L[(size_t)row * 256 + j] = f2bf(val);
    }
    {
      uint4 u0 = *(const uint4*)(pr + C_AL), u1 = *(const uint4*)(pr + C_AL + 8);
      float al[16] = {lo16(u0.x), hi16(u0.x), lo16(u0.y), hi16(u0.y), lo16(u0.z), hi16(u0.z), lo16(u0.w), hi16(u0.w),
                      lo16(u1.x), hi16(u1.x), lo16(u1.y), hi16(u1.y), lo16(u1.z), hi16(u1.z), lo16(u1.w), hi16(u1.w)};
#pragma unroll
      for (int h2 = 0; h2 < 2; ++h2) {
        const int k = tid + 256 * h2;
        float a = ba[k];
#pragma unroll
        for (int i = 0; i < 16; ++i) a += al[i] * wa2[i * 512 + k];
        const float la = -softplusf_(-a) * (1.f / 16.f);
        p->LA[(size_t)row * 512 + k] = f2bf(la);
      }
    }
  }
  for (int s = blockIdx.x; s < NSEQ; s += G) {
    const Seq q = get_seq(s);
    const bf16_t* pr = p->PROJ + (size_t)(q.row0 + q.T - 1) * LD0 + RW0;
    float* o = p->out + (q.sample ? O_SSHIFT + (size_t)q.b * 3328 : O_PSHIFT + (size_t)q.b * 3328);
    for (int j = tid; j < 3328; j += 256) o[j] = bf2f(pr[j]);
  }
}

#ifndef REP_SEL
#define REP_SEL -1
#endif
__device__ __forceinline__ int next_task(unsigned* ctr, char* smem, unsigned n) {
  int* st = (int*)(smem + 65024);
  __syncthreads();
  if (threadIdx.x == 0) *st = (int)atomicAdd(ctr, n);
  __syncthreads();
  return *st;
}

typedef float f32x2 __attribute__((ext_vector_type(2)));
__device__ __forceinline__ float dpp_f(float v, const int ctrl_sel) {
  int x = __float_as_int(v), r;
  if (ctrl_sel == 0) r = __builtin_amdgcn_update_dpp(0, x, 0xB1, 0xF, 0xF, true);
  else if (ctrl_sel == 1) r = __builtin_amdgcn_update_dpp(0, x, 0x4E, 0xF, 0xF, true);
  else if (ctrl_sel == 2) r = __builtin_amdgcn_update_dpp(0, x, 0x141, 0xF, 0xF, true);
  else r = __builtin_amdgcn_update_dpp(0, x, 0x140, 0xF, 0xF, true);
  return __int_as_float(r);
}
__device__ __forceinline__ float sum4(float v) { v += dpp_f(v, 0); v += dpp_f(v, 1); return v; }
__device__ __forceinline__ float sum8(float v) { v = sum4(v); v += dpp_f(v, 2); return v; }
__device__ __forceinline__ float wave_sum3(float v) {
  v = sum8(v); v += dpp_f(v, 3);
  const float a = __int_as_float(__builtin_amdgcn_readlane(__float_as_int(v), 0));
  const float b = __int_as_float(__builtin_amdgcn_readlane(__float_as_int(v), 16));
  const float c = __int_as_float(__builtin_amdgcn_readlane(__float_as_int(v), 32));
  const float d = __int_as_float(__builtin_amdgcn_readlane(__float_as_int(v), 48));
  return (a + b) + (c + d);
}
__device__ __forceinline__ float wave_sum2(float v) {
  v = sum8(v); v += dpp_f(v, 3);
  v += __shfl_xor(v, 16); v += __shfl_xor(v, 32);
  return v;
}

static __device__ __forceinline__ void gla_task(KP p, int s, int h, int cgp, char* smem) {
  float* sq = (float*)smem; float* sk = sq + 2048; float* sea = sk + 2048; float* sv = sea + 2048; float* so = sv + 512;
  const Seq q = get_seq(s);
  const int tid = threadIdx.x, cp = tid >> 4, k8 = tid & 15;
  const int stt = tid >> 4, skc = tid & 15;
  bf16_t* PROJ = p->PROJ; const bf16_t* LA = p->LA;
  const int nrep_ = q.T > 8 ? ((REP_SEL < 0 || REP_SEL == 0) ? p->rep_long : 1) : p->rep_short;
  for (int rep_ = 0; rep_ < nrep_; ++rep_) {
  const bool last_ = rep_ == nrep_ - 1;
  f32x2 S0[4], S1[4];
  if (q.sample) {
    const float* st = p->in[I_SGLA] + ((size_t)(q.b * 4 + h) * 128 + k8 * 8) * 256 + cgp * 32 + 2 * cp;
#pragma unroll
    for (int u = 0; u < 4; ++u) {
      const f32x2 ra = *(const f32x2*)(st + (size_t)(2 * u) * 256), rb = *(const f32x2*)(st + (size_t)(2 * u + 1) * 256);
      S0[u] = (f32x2){ra.x, rb.x}; S1[u] = (f32x2){ra.y, rb.y};
    }
  } else {
#pragma unroll
    for (int u = 0; u < 4; ++u) { S0[u] = (f32x2){0.f, 0.f}; S1[u] = (f32x2){0.f, 0.f}; }
  }
  const float qs = 0.08838834764831845f;
  uint4 uq = make_uint4(0, 0, 0, 0), uk = uq, ul = uq; unsigned uv = 0;
#define GLA_PREFETCH(T0)                                                                   \
  {                                                                                        \
    const int ns_ = min(16, q.T - (T0));                                                   \
    if (stt < ns_) {                                                                       \
      const size_t row_ = (size_t)(q.row0 + (T0) + stt);                                   \
      const bf16_t* pr_ = PROJ + row_ * LD0;                                               \
      uq = *(const uint4*)(pr_ + C_Q + h * 128 + skc * 8);                                 \
      uk = *(const uint4*)(pr_ + C_K + h * 128 + skc * 8);                                 \
      ul = *(const uint4*)(LA + row_ * 512 + h * 128 + skc * 8);                           \
      uv = *(const unsigned*)(pr_ + C_V + h * 256 + cgp * 32 + skc * 2);                   \
    }                                                                                      \
  }
  GLA_PREFETCH(0);
  for (int t0 = 0; t0 < q.T; t0 += 16) {
    const int ns = min(16, q.T - t0);
    __syncthreads();
    if (stt < ns) {
      f32x4* dq = (f32x4*)(sq + stt * 128 + skc * 8); f32x4* dk = (f32x4*)(sk + stt * 128 + skc * 8); f32x4* de = (f32x4*)(sea + stt * 128 + skc * 8);
      dq[0] = (f32x4){lo16(uq.x) * qs, hi16(uq.x) * qs, lo16(uq.y) * qs, hi16(uq.y) * qs};
      dq[1] = (f32x4){lo16(uq.z) * qs, hi16(uq.z) * qs, lo16(uq.w) * qs, hi16(uq.w) * qs};
      dk[0] = (f32x4){lo16(uk.x), hi16(uk.x), lo16(uk.y), hi16(uk.y)};
      dk[1] = (f32x4){lo16(uk.z), hi16(uk.z), lo16(uk.w), hi16(uk.w)};
      de[0] = (f32x4){__expf(lo16(ul.x)), __expf(hi16(ul.x)), __expf(lo16(ul.y)), __expf(hi16(ul.y))};
      de[1] = (f32x4){__expf(lo16(ul.z)), __expf(hi16(ul.z)), __expf(lo16(ul.w)), __expf(hi16(ul.w))};
      *(f32x2*)(sv + stt * 32 + skc * 2) = (f32x2){lo16(uv), hi16(uv)};
    }
    __syncthreads();
    if (t0 + 16 < q.T) GLA_PREFETCH(t0 + 16);
    struct GlaOps { f32x2 vv; f32x4 q[2], k[2], e[2]; };
    auto gla_load = [&](const int tt, GlaOps& o) {
      o.vv = *(const f32x2*)(sv + tt * 32 + 2 * cp);
      const f32x4* q4 = (const f32x4*)(sq + tt * 128 + k8 * 8);
      const f32x4* k4 = (const f32x4*)(sk + tt * 128 + k8 * 8);
      const f32x4* e4 = (const f32x4*)(sea + tt * 128 + k8 * 8);
      o.q[0] = q4[0]; o.q[1] = q4[1]; o.k[0] = k4[0]; o.k[1] = k4[1]; o.e[0] = e4[0]; o.e[1] = e4[1];
    };
    auto gla_math = [&](const GlaOps& o, float& y0, float& y1) {
      const f32x2 v0 = (f32x2){o.vv.x, o.vv.x}, v1 = (f32x2){o.vv.y, o.vv.y};
      S0[0] = o.e[0].xy * S0[0] + o.k[0].xy * v0; S0[1] = o.e[0].zw * S0[1] + o.k[0].zw * v0;
      S0[2] = o.e[1].xy * S0[2] + o.k[1].xy * v0; S0[3] = o.e[1].zw * S0[3] + o.k[1].zw * v0;
      S1[0] = o.e[0].xy * S1[0] + o.k[0].xy * v1; S1[1] = o.e[0].zw * S1[1] + o.k[0].zw * v1;
      S1[2] = o.e[1].xy * S1[2] + o.k[1].xy * v1; S1[3] = o.e[1].zw * S1[3] + o.k[1].zw * v1;
      f32x2 a = o.q[0].xy * S0[0], b2 = o.q[0].zw * S0[1], c2 = o.q[0].xy * S1[0], d2 = o.q[0].zw * S1[1];
      a = o.q[1].xy * S0[2] + a; b2 = o.q[1].zw * S0[3] + b2; c2 = o.q[1].xy * S1[2] + c2; d2 = o.q[1].zw * S1[3] + d2;
      a += b2; c2 += d2;
      y0 = a.x + a.y; y1 = c2.x + c2.y;
    };
    {
      GlaOps ga, gb;
      gla_load(0, ga);
#pragma unroll 1
      for (int tt = 0; tt < ns; tt += 4) {
        float yp0[4], yp1[4];
#pragma unroll
        for (int u = 0; u < 4; u += 2) {
          gla_load(tt + u + 1, gb);
          __builtin_amdgcn_sched_barrier(0);
          gla_math(ga, yp0[u], yp1[u]);
          __builtin_amdgcn_sched_barrier(0);
          gla_load(min(tt + u + 2, ns - 1), ga);
          __builtin_amdgcn_sched_barrier(0);
          gla_math(gb, yp0[u + 1], yp1[u + 1]);
          __builtin_amdgcn_sched_barrier(0);
        }
#pragma unroll
        for (int u = 0; u < 4; ++u) {
          yp0[u] = sum8(yp0[u]); yp0[u] += dpp_f(yp0[u], 3);
          yp1[u] = sum8(yp1[u]); yp1[u] += dpp_f(yp1[u], 3);
        }
        if (k8 == 0) {
#pragma unroll
          for (int u = 0; u < 4; ++u) *(f32x2*)(so + (tt + u) * 32 + 2 * cp) = (f32x2){yp0[u], yp1[u]};
        }
        __builtin_amdgcn_sched_barrier(0);
      }
    }
    __syncthreads();
    if (stt < ns && last_) {
      const size_t row = (size_t)(q.row0 + t0 + stt);
      *(unsigned*)(PROJ + row * LD0 + C_V + h * 256 + cgp * 32 + skc * 2) = pack2(so[stt * 32 + skc * 2], so[stt * 32 + skc * 2 + 1]);
    }
  }
#undef GLA_PREFETCH
  float* dst = p->out + (q.sample ? O_SGLA : O_PGLA) + ((size_t)(q.b * 4 + h) * 128 + k8 * 8) * 256 + cgp * 32 + 2 * cp;
  if (last_) {
#pragma unroll
    for (int u = 0; u < 4; ++u) {
      *(f32x2*)(dst + (size_t)(2 * u) * 256) = (f32x2){S0[u].x, S1[u].x};
      *(f32x2*)(dst + (size_t)(2 * u + 1) * 256) = (f32x2){S0[u].y, S1[u].y};
    }
  }
  }

}

static __device__ __forceinline__ void rwkv_task(KP p, int s, int h, char* smem) {
  float* sr = (float*)smem; float* sw = sr + 1024; float* skp = sw + 1024; float* snk = skp + 1024; float* sb = snk + 1024;
  float* sv = sb + 1024; float* sy = sv + 1024; float* sbon = sy + 1024; float* scar = sbon + 16;
  float* sg = scar + 384 + 512;
  float* spar = scar + 384;
  const Seq q = get_seq(s);
  const int tid = threadIdx.x, lane = tid & 63, wid = tid >> 6;
  const int rp = tid >> 3, j8 = tid & 7;
  bf16_t* PROJ = p->PROJ; const bf16_t* EW = p->EW; const bf16_t* AA = p->AA; const bf16_t* GG = p->GG;
  const int nrep_ = q.T > 8 ? ((REP_SEL < 0 || REP_SEL == 1) ? p->rep_long : 1) : p->rep_short;
  for (int rep_ = 0; rep_ < nrep_; ++rep_) {
  const bool last_ = rep_ == nrep_ - 1;
  f32x2 S0[4], S1[4];
  if (q.sample) {
    const f32x4* st0 = (const f32x4*)(p->in[I_SRWKV] + ((size_t)(q.b * 16 + h) * 64 + 2 * rp) * 64 + j8 * 8);
    f32x4 v = st0[0]; S0[0] = v.xy; S0[1] = v.zw; v = st0[1]; S0[2] = v.xy; S0[3] = v.zw;
    v = st0[16]; S1[0] = v.xy; S1[1] = v.zw; v = st0[17]; S1[2] = v.xy; S1[3] = v.zw;
  } else {
#pragma unroll
    for (int u = 0; u < 4; ++u) { S0[u] = (f32x2){0.f, 0.f}; S1[u] = (f32x2){0.f, 0.f}; }
  }
  __syncthreads();
  if (tid < 192) {
    const int a = tid >> 6, j = tid & 63;
    scar[a * 64 + j] = q.sample ? p->in[I_SSHIFT][(size_t)q.b * 3328 + a * 1024 + h * 64 + j] : 0.f;
  }
  const int col = h * 64 + lane;
  if (tid < 64) {
    spar[lane] = p->in[I_MU][col]; spar[64 + lane] = p->in[I_MU][1024 + col]; spar[128 + lane] = p->in[I_MU][2048 + col];
    spar[192 + lane] = p->in[I_KK][col]; spar[256 + lane] = p->in[I_KA][col]; spar[320 + lane] = p->in[I_RK][col];
    spar[384 + lane] = p->in[I_LNW][col]; spar[448 + lane] = p->in[I_LNB][col];
  }
  unsigned xr[4], xk[4], xv[4], xe[4], xa[4], xg[4], yr = 0, yk = 0, yv = 0;
#pragma unroll
  for (int u = 0; u < 4; ++u) { xr[u] = xk[u] = xv[u] = xe[u] = xa[u] = xg[u] = 0; }
#define RWKV_PREFETCH(T0)                                                                  \
  {                                                                                        \
    const int ns_ = min(16, q.T - (T0));                                                   \
    _Pragma("unroll") for (int u = 0; u < 4; ++u) {                                        \
      const int tt_ = 4 * wid + u;                                                         \
      if (tt_ < ns_) {                                                                     \
        const size_t row_ = (size_t)(q.row0 + (T0) + tt_);                                 \
        const bf16_t* pr_ = PROJ + row_ * LD0;                                             \
        xr[u] = pr_[C_R + col]; xk[u] = pr_[C_KR + col]; xv[u] = pr_[C_VR + col];          \
        xe[u] = EW[row_ * 1024 + col]; xa[u] = AA[row_ * 1024 + col]; xg[u] = GG[row_ * 1024 + col]; \
      }                                                                                    \
    }                                                                                      \
    if (wid > 0 && 4 * wid < ns_) {                                                        \
      const bf16_t* pr_ = PROJ + (size_t)(q.row0 + (T0) + 4 * wid - 1) * LD0;              \
      yr = pr_[C_R + col]; yk = pr_[C_KR + col]; yv = pr_[C_VR + col];                     \
    }                                                                                      \
  }
  RWKV_PREFETCH(0);
  int par = 0;
  for (int t0 = 0; t0 < q.T; t0 += 16, par ^= 1) {
    const int ns = min(16, q.T - t0);
    __syncthreads();
    {
      const float mu_r = spar[lane], mu_k = spar[64 + lane], mu_v = spar[128 + lane];
      const float k_k = spar[192 + lane], k_a = spar[256 + lane], r_k = spar[320 + lane];
      float pr_r, pr_k, pr_v;
      if (wid > 0) { pr_r = bf2f(yr); pr_k = bf2f(yk); pr_v = bf2f(yv); }
      else { pr_r = scar[par * 192 + lane]; pr_k = scar[par * 192 + 64 + lane]; pr_v = scar[par * 192 + 128 + lane]; }
#pragma unroll
      for (int u = 0; u < 4; ++u) {
        const int tt = 4 * wid + u;
        const float cr = bf2f(xr[u]), ck = bf2f(xk[u]), cv = bf2f(xv[u]);
        if (tt < ns) {
          if (tt == ns - 1) { scar[(par ^ 1) * 192 + lane] = cr; scar[(par ^ 1) * 192 + 64 + lane] = ck; scar[(par ^ 1) * 192 + 128 + lane] = cv; }
          const float r = cr + (pr_r - cr) * mu_r, kr = ck + (pr_k - ck) * mu_k, vr = cv + (pr_v - cv) * mu_v;
          const float ew = bf2f(xe[u]);
          const float a = bf2f(xa[u]);
          const float w = __expf(-ew);
          const float kkr = kr * k_k;
          const float ss = wave_sum3(kkr * kkr);
          const float kk = kkr * rsqrtf(fmaxf(ss, 1e-24f));
          const float kp = kr * (1.f + (a - 1.f) * k_a);
          const float bon = wave_sum3(r * kp * r_k);
          sr[tt * 64 + lane] = r; sw[tt * 64 + lane] = w; skp[tt * 64 + lane] = kp; snk[tt * 64 + lane] = -kk;
          sb[tt * 64 + lane] = kk * a; sv[tt * 64 + lane] = vr; sg[tt * 64 + lane] = bf2f(xg[u]);
          if (lane == 0) sbon[tt] = bon;
        }
        pr_r = cr; pr_k = ck; pr_v = cv;
      }
    }
    __syncthreads();
    if (t0 + 16 < q.T) RWKV_PREFETCH(t0 + 16);
    struct RwN { f32x2 vi; f32x4 n[2]; };
    struct RwW { f32x4 w[2], b[2], k[2], r[2]; };
    auto rw_loadn = [&](const int tt, RwN& o) {
      o.vi = *(const f32x2*)(sv + tt * 64 + 2 * rp);
      const f32x4* n4 = (const f32x4*)(snk + tt * 64 + j8 * 8);
      o.n[0] = n4[0]; o.n[1] = n4[1];
    };
    auto rw_loadw = [&](const int tt, RwW& o) {
      const f32x4* w4 = (const f32x4*)(sw + tt * 64 + j8 * 8);
      const f32x4* b4 = (const f32x4*)(sb + tt * 64 + j8 * 8);
      const f32x4* k4 = (const f32x4*)(skp + tt * 64 + j8 * 8);
      const f32x4* r4 = (const f32x4*)(sr + tt * 64 + j8 * 8);
      o.w[0] = w4[0]; o.w[1] = w4[1]; o.b[0] = b4[0]; o.b[1] = b4[1];
      o.k[0] = k4[0]; o.k[1] = k4[1]; o.r[0] = r4[0]; o.r[1] = r4[1];
    };
    auto rw_sa = [&](const RwN& o, const RwW& w, float& sa0, float& sa1) {
      f32x2 a0 = S0[0] * o.n[0].xy, a0b = S0[1] * o.n[0].zw, a1 = S1[0] * o.n[0].xy, a1b = S1[1] * o.n[0].zw;
      a0 = S0[2] * o.n[1].xy + a0; a0b = S0[3] * o.n[1].zw + a0b; a1 = S1[2] * o.n[1].xy + a1; a1b = S1[3] * o.n[1].zw + a1b;
      a0 += a0b; a1 += a1b;
      sa0 = sum8(a0.x + a0.y); sa1 = sum8(a1.x + a1.y);
      const f32x2 v0 = (f32x2){o.vi.x, o.vi.x}, v1 = (f32x2){o.vi.y, o.vi.y};
      S0[0] = S0[0] * w.w[0].xy + v0 * w.k[0].xy; S0[1] = S0[1] * w.w[0].zw + v0 * w.k[0].zw;
      S0[2] = S0[2] * w.w[1].xy + v0 * w.k[1].xy; S0[3] = S0[3] * w.w[1].zw + v0 * w.k[1].zw;
      S1[0] = S1[0] * w.w[0].xy + v1 * w.k[0].xy; S1[1] = S1[1] * w.w[0].zw + v1 * w.k[0].zw;
      S1[2] = S1[2] * w.w[1].xy + v1 * w.k[1].xy; S1[3] = S1[3] * w.w[1].zw + v1 * w.k[1].zw;
    };
    auto rw_upd = [&](const RwW& o, const float sa0, const float sa1, float& y0, float& y1) {
      const f32x2 s0 = (f32x2){sa0, sa0}, s1 = (f32x2){sa1, sa1};
      S0[0] = s0 * o.b[0].xy + S0[0]; S0[1] = s0 * o.b[0].zw + S0[1]; S0[2] = s0 * o.b[1].xy + S0[2]; S0[3] = s0 * o.b[1].zw + S0[3];
      S1[0] = s1 * o.b[0].xy + S1[0]; S1[1] = s1 * o.b[0].zw + S1[1]; S1[2] = s1 * o.b[1].xy + S1[2]; S1[3] = s1 * o.b[1].zw + S1[3];
      f32x2 ya = S0[0] * o.r[0].xy, yb = S0[1] * o.r[0].zw, yc = S1[0] * o.r[0].xy, yd = S1[1] * o.r[0].zw;
      ya = S0[2] * o.r[1].xy + ya; yb = S0[3] * o.r[1].zw + yb; yc = S1[2] * o.r[1].xy + yc; yd = S1[3] * o.r[1].zw + yd;
      ya += yb; yc += yd;
      y0 = ya.x + ya.y; y1 = yc.x + yc.y;
    };
    {
      RwN na; RwW wv;
      rw_loadn(0, na);
#pragma unroll 1
      for (int tt = 0; tt < ns; tt += 4) {
        float yp0[4], yp1[4];
#pragma unroll
        for (int u = 0; u < 4; ++u) {
          rw_loadw(tt + u, wv);
          __builtin_amdgcn_sched_barrier(0);
          float sa0, sa1;
          rw_sa(na, wv, sa0, sa1);
          __builtin_amdgcn_sched_barrier(0);
          rw_loadn(min(tt + u + 1, ns - 1), na);
          __builtin_amdgcn_sched_barrier(0);
          rw_upd(wv, sa0, sa1, yp0[u], yp1[u]);
          __builtin_amdgcn_sched_barrier(0);
        }
#pragma unroll
        for (int u = 0; u < 4; ++u) { yp0[u] = sum8(yp0[u]); yp1[u] = sum8(yp1[u]); }
        if (j8 == 0) {
#pragma unroll
          for (int u = 0; u < 4; ++u) *(f32x2*)(sy + (tt + u) * 64 + 2 * rp) = (f32x2){yp0[u], yp1[u]};
        }
        __builtin_amdgcn_sched_barrier(0);
      }
    }
    __syncthreads();
#pragma unroll
    for (int u = 0; u < 4; ++u) {
      const int tt = 4 * wid + u;
      if (tt < ns) {
        const size_t row = (size_t)(q.row0 + t0 + tt);
        const float y = sy[tt * 64 + lane];
        const float s1 = wave_sum3(y), s2 = wave_sum3(y * y);
        const float mean = s1 * (1.f / 64.f);
        const float var = fmaxf(s2 * (1.f / 64.f) - mean * mean, 0.f);
        const float gn = (y - mean) * rsqrtf(var + 64e-5f) * spar[384 + lane] + spar[448 + lane];
        const float o = (gn + sbon[tt] * sv[tt * 64 + lane]) * sg[tt * 64 + lane];
        if (last_) PROJ[row * LD0 + C_R + col] = f2bf(o);
      }
    }
  }
#undef RWKV_PREFETCH
  f32x4* dst = (f32x4*)(p->out + (q.sample ? O_SRWKV : O_PRWKV) + ((size_t)(q.b * 16 + h) * 64 + 2 * rp) * 64 + j8 * 8);
  if (last_) {
    dst[0] = (f32x4){S0[0].x, S0[0].y, S0[1].x, S0[1].y}; dst[1] = (f32x4){S0[2].x, S0[2].y, S0[3].x, S0[3].y};
    dst[16] = (f32x4){S1[0].x, S1[0].y, S1[1].x, S1[1].y}; dst[17] = (f32x4){S1[2].x, S1[2].y, S1[3].x, S1[3].y};
  }
  }

}

__device__ void scan0_phase(KP p, char* smem) {
  const int NL = 384, NS = 2048 + 4096;
  const int G = (int)gridDim.x, b = (int)blockIdx.x;
  int next_long, long_stride;
  if (G >= 512) { next_long = b < 256 ? b : ((b >= 384 && b < 512) ? b - 128 : NL); long_stride = 1 << 20; }
  else { next_long = b; long_stride = G; }
  int cur = 0, batch_end = 0;
  for (;;) {
    int t;
    if (next_long < NL) { t = next_long; next_long += long_stride; }
    else {
      if (cur >= batch_end) {
        const int base = next_task(p->ctr + 0, smem, 8);
        if (base >= NS) break;
        cur = base; batch_end = min(base + 8, NS);
      }
      t = NL + cur++;
    }
    int is_rwkv, sq, hh, cg_ = 0;
    if (t < 128) { is_rwkv = 1; sq = t >> 4; hh = t & 15; }
    else if (t < 384) { t -= 128; is_rwkv = 0; sq = t >> 5; hh = (t >> 3) & 3; cg_ = t & 7; }
    else if (t < 384 + 2048) { t -= 384; is_rwkv = 1; sq = 8 + (t >> 4); hh = t & 15; }
    else { t -= 384 + 2048; is_rwkv = 0; sq = 8 + (t >> 5); hh = (t >> 3) & 3; cg_ = t & 7; }
    if (is_rwkv) rwkv_task(p, sq, hh, smem); else gla_task(p, sq, hh, cg_, smem);
  }
}

__device__ void gla_norm_phase(KP p) {
  const int lane = threadIdx.x & 63, wid = threadIdx.x >> 6;
  const int nw = gridDim.x * 4;
  const float* gn = p->in[I_GLA_GN];
  const float4 g4 = *(const float4*)(gn + lane * 4);
  for (int it = blockIdx.x * 4 + wid; it < MROWS * 4; it += nw) {
    const size_t row = it >> 2; const int h = it & 3;
    bf16_t* po = p->PROJ + row * LD0 + C_V + h * 256 + lane * 4;
    const uint2 uo = *(const uint2*)po;
    const uint2 ug = *(const uint2*)(p->PROJ + row * LD0 + C_OG + h * 256 + lane * 4);
    const float o0 = lo16(uo.x), o1 = hi16(uo.x), o2 = lo16(uo.y), o3 = hi16(uo.y);
    const float ss = wave_sum(o0 * o0 + o1 * o1 + o2 * o2 + o3 * o3);
    const float rs = rsqrtf(ss * (1.f / 256.f) + 1e-5f);
    uint2 r;
    r.x = pack2(o0 * rs * g4.x * siluf_(lo16(ug.x)), o1 * rs * g4.y * siluf_(hi16(ug.x)));
    r.y = pack2(o2 * rs * g4.z * siluf_(lo16(ug.y)), o3 * rs * g4.w * siluf_(hi16(ug.y)));
    *(uint2*)po = r;
  }
}

__device__ void prep1_phase(KP p) {
  const int tid = threadIdx.x;
  const int G = (int)gridDim.x;
  for (int row = blockIdx.x; row < MROWS; row += G) {
    int t, b, sample;
    if (row < RP) { t = row & 2047; b = row >> 11; sample = 0; } else { const int rr = row - RP; b = rr >> 3; t = rr & 7; sample = 1; }
    const bf16_t* pr = p->PROJ + (size_t)row * LD1;
    for (int c = tid; c < 2560; c += 256) {
      const bool lru = c < 1024;
      const int ch = lru ? c : c - 1024;
      const int colx = lru ? D_XBR + ch : D_XBC + ch;
      const int nch = lru ? 1024 : 1536;
      const float* cw = lru ? p->in[I_LCW] : p->in[I_SCW];
      const float* stc = lru ? p->in[I_SLRUC] : p->in[I_SSSDC];
      float acc = (lru ? p->in[I_LCB] : p->in[I_SCB])[ch];
#pragma unroll
      for (int m = 0; m < 4; ++m) {
        float u = 0.f;
        if (t - m >= 0) u = bf2f(pr[colx - m * LD1]);
        else if (sample) u = stc[((size_t)b * 3 + (3 + t - m)) * nch + ch];
        acc += u * cw[(3 - m) * nch + ch];
      }
      if (lru) p->XC[(size_t)row * 1024 + ch] = f2bf(acc);
      else p->XBC[(size_t)row * 1536 + ch] = f2bf(siluf_(acc));
    }
    if (tid < 16) p->DT[(size_t)row * 16 + tid] = softplusf_(bf2f(pr[D_DT + tid]) + p->in[I_DTB][tid]);
  }
  for (int s = blockIdx.x; s < NSEQ; s += G) {
    const Seq q = get_seq(s);
    for (int e = tid; e < 3 * 2560; e += 256) {
      const int j = e / 2560, c = e - j * 2560;
      const size_t row = (size_t)(q.row0 + q.T - 3 + j);
      if (c < 1024) {
        float* o = p->out + (q.sample ? O_SLRUC : O_PLRUC) + ((size_t)q.b * 3 + j) * 1024 + c;
        *o = bf2f(p->PROJ[row * LD1 + D_XBR + c]);
      } else {
        const int ch = c - 1024;
        float* o = p->out + (q.sample ? O_SSSDC : O_PSSDC) + ((size_t)q.b * 3 + j) * 1536 + ch;
        *o = bf2f(p->PROJ[row * LD1 + D_XBC + ch]);
      }
    }
  }
}

__device__ __forceinline__ float fast_tanh(float u) { return 1.f - 2.f / (__expf(2.f * u) + 1.f); }
static __device__ __forceinline__ void lru_task(KP p, int s, int cq) {
  const Seq q = get_seq(s);
  const int ch = cq * 256 + threadIdx.x;
  bf16_t* PROJ = p->PROJ; const bf16_t* GX = p->GX;
  const int nrep_ = q.T > 8 ? ((REP_SEL < 0 || REP_SEL == 2) ? p->rep_long : 1) : p->rep_short;
  for (int rep_ = 0; rep_ < nrep_; ++rep_) {
  const bool last_ = rep_ == nrep_ - 1;
  float h = q.sample ? p->in[I_SLRU][(size_t)q.b * 1024 + ch] : 0.f;
  unsigned nla[8], ngx[8], ngt[8];
#define LRU_PREFETCH(T0)                                                          \
  _Pragma("unroll") for (int u = 0; u < 8; ++u) {                                 \
    const size_t row_ = (size_t)(q.row0 + (T0) + u);                              \
    nla[u] = PROJ[row_ * LD1 + D_XBR + ch]; ngx[u] = GX[row_ * 1024 + ch]; ngt[u] = PROJ[row_ * LD1 + D_GATE + ch]; \
  }
  LRU_PREFETCH(0);
  for (int t0 = 0; t0 < q.T; t0 += 8) {
    float a[8], bt[8], ge[8];
#pragma unroll
    for (int u = 0; u < 8; ++u) {
      const float la = bf2f(nla[u]), gx = bf2f(ngx[u]), gt = bf2f(ngt[u]);
      a[u] = __expf(la);
      const float x = 2.f * la;
      const float om = (x > -0.1f) ? -x * (1.f + x * (0.5f + x * (0.16666667f + x * 0.041666668f))) : 1.f - __expf(x);
      bt[u] = __builtin_amdgcn_sqrtf(fmaxf(om, 0.f)) * gx;
      const float uu = 0.7978845608028654f * (gt + 0.044715f * gt * gt * gt);
      ge[u] = 0.5f * gt * (1.f + fast_tanh(uu));
    }
    if (t0 + 8 < q.T) LRU_PREFETCH(t0 + 8);
#pragma unroll
    for (int u = 0; u < 8; ++u) {
      const size_t row = (size_t)(q.row0 + t0 + u);
      h = fmaf(a[u], h, bt[u]);
      if (last_) PROJ[row * LD1 + D_GATE + ch] = f2bf(h * ge[u]);
    }
  }
#undef LRU_PREFETCH
  if (last_) p->out[(q.sample ? O_SLRU : O_PLRU) + (size_t)q.b * 1024 + ch] = h;
  }

}

static __device__ __forceinline__ void ssd_task(KP p, int s, int h, int pg, char* smem) {
  float* sB = (float*)smem; float* sC = sB + 4096; float* sx = sC + 4096; float* so = sx + 1024; float* sda = so + 1024; float* sdt = sda + 32;
  const Seq q = get_seq(s);
  const int tid = threadIdx.x, c = tid >> 3, ng = tid & 7;
  const int stt = tid >> 4, skc = tid & 15;
  const int g = h >> 3;
  bf16_t* PROJ = p->PROJ; const bf16_t* XBC = p->XBC; const float* DT = p->DT;
  f32x2 S[8];
  if (q.sample) {
    const f32x4* st = (const f32x4*)(p->in[I_SSSD] + ((size_t)(q.b * 16 + h) * 64 + pg * 32 + c) * 128 + ng * 16);
#pragma unroll
    for (int u = 0; u < 4; ++u) { f32x4 v = st[u]; S[2 * u] = v.xy; S[2 * u + 1] = v.zw; }
  } else {
#pragma unroll
    for (int u = 0; u < 8; ++u) S[u] = (f32x2){0.f, 0.f};
  }
  const float Ah = -__expf(p->in[I_ALOG][h]);
  const float Dh = p->in[I_SD][h];
  uint4 ub0 = make_uint4(0, 0, 0, 0), uc0 = ub0, ub1 = ub0, uc1 = ub0; unsigned ux0 = 0, uz0 = 0, ux1 = 0, uz1 = 0; float udt0 = 0.f, udt1 = 0.f;
#define SSD_PF1(T0, R, UB, UC, UX, UZ, UDT)                                                \
    if ((R) < ns_) {                                                                       \
      const size_t row_ = (size_t)(q.row0 + (T0) + (R));                                   \
      const bf16_t* px_ = XBC + row_ * 1536;                                               \
      UB = *(const uint4*)(px_ + 1024 + g * 128 + skc * 8);                                \
      UC = *(const uint4*)(px_ + 1280 + g * 128 + skc * 8);                                \
      UX = *(const unsigned*)(px_ + h * 64 + pg * 32 + skc * 2);                           \
      UZ = *(const unsigned*)(PROJ + row_ * LD1 + D_Z + h * 64 + pg * 32 + skc * 2);       \
      UDT = DT[row_ * 16 + h];                                                             \
    }
#define SSD_PREFETCH(T0)                                                                   \
  { const int ns_ = min(32, q.T - (T0));                                                   \
    SSD_PF1(T0, stt, ub0, uc0, ux0, uz0, udt0) SSD_PF1(T0, stt + 16, ub1, uc1, ux1, uz1, udt1) }
#define SSD_ST1(R, UB, UC, UX, UDT)                                                        \
    if ((R) < ns) {                                                                        \
      f32x4* db = (f32x4*)(sB + (R) * 128 + skc * 8); f32x4* dc = (f32x4*)(sC + (R) * 128 + skc * 8); \
      db[0] = (f32x4){lo16(UB.x), hi16(UB.x), lo16(UB.y), hi16(UB.y)};                     \
      db[1] = (f32x4){lo16(UB.z), hi16(UB.z), lo16(UB.w), hi16(UB.w)};                     \
      dc[0] = (f32x4){lo16(UC.x), hi16(UC.x), lo16(UC.y), hi16(UC.y)};                     \
      dc[1] = (f32x4){lo16(UC.z), hi16(UC.z), lo16(UC.w), hi16(UC.w)};                     \
      *(f32x2*)(sx + (R) * 32 + skc * 2) = (f32x2){lo16(UX), hi16(UX)};                    \
      if (skc == 0) { sdt[(R)] = UDT; sda[(R)] = __expf(UDT * Ah); }                       \
    }
  SSD_PREFETCH(0);
  for (int t0 = 0; t0 < q.T; t0 += 32) {
    const int ns = min(32, q.T - t0);
    __syncthreads();
    const unsigned zc0 = uz0, zc1 = uz1;
    SSD_ST1(stt, ub0, uc0, ux0, udt0)
    SSD_ST1(stt + 16, ub1, uc1, ux1, udt1)
    __syncthreads();
    if (t0 + 32 < q.T) SSD_PREFETCH(t0 + 32);
    struct SsdOps { float xv, da, dt; f32x4 b[4], c[4]; };
    auto ssd_load = [&](const int tt, SsdOps& o) {
      o.xv = sx[tt * 32 + c]; o.da = sda[tt]; o.dt = sdt[tt];
      const f32x4* b4 = (const f32x4*)(sB + tt * 128 + ng * 16);
      const f32x4* c4 = (const f32x4*)(sC + tt * 128 + ng * 16);
#pragma unroll
      for (int u = 0; u < 4; ++u) { o.b[u] = b4[u]; o.c[u] = c4[u]; }
    };
    auto ssd_math = [&](const SsdOps& o) -> float {
      const float dx = o.dt * o.xv;
      const f32x2 da2 = (f32x2){o.da, o.da}, dx2 = (f32x2){dx, dx};
      f32x2 ya = (f32x2){0.f, 0.f}, yb = (f32x2){0.f, 0.f};
#pragma unroll
      for (int u = 0; u < 4; ++u) {
        S[2 * u] = da2 * S[2 * u] + dx2 * o.b[u].xy;         ya = o.c[u].xy * S[2 * u] + ya;
        S[2 * u + 1] = da2 * S[2 * u + 1] + dx2 * o.b[u].zw; yb = o.c[u].zw * S[2 * u + 1] + yb;
      }
      ya += yb;
      return ya.x + ya.y + (ng == 0 ? Dh * o.xv : 0.f);
    };
    if (ns == 32) {
      SsdOps oa, ob;
      ssd_load(0, oa);
#pragma unroll
      for (int hh = 0; hh < 2; ++hh) {
        float yv[16];
#pragma unroll
        for (int tt = 0; tt < 16; tt += 4) {
#pragma unroll
          for (int u = 0; u < 4; u += 2) {
            ssd_load(hh * 16 + tt + u + 1, ob);
            __builtin_amdgcn_sched_barrier(0);
            yv[tt + u] = ssd_math(oa);
            __builtin_amdgcn_sched_barrier(0);
            ssd_load(min(hh * 16 + tt + u + 2, 31), oa);
            __builtin_amdgcn_sched_barrier(0);
            yv[tt + u + 1] = ssd_math(ob);
            __builtin_amdgcn_sched_barrier(0);
          }
#pragma unroll
          for (int u = 0; u < 4; ++u) yv[tt + u] = sum8(yv[tt + u]);
          __builtin_amdgcn_sched_barrier(0);
        }
        if (ng == 0) {
#pragma unroll
          for (int tt = 0; tt < 16; ++tt) so[(hh * 16 + tt) * 32 + c] = yv[tt];
        }
      }
    } else {
      for (int tt = 0; tt < ns; ++tt) { SsdOps o; ssd_load(tt, o); const float y = sum8(ssd_math(o)); if (ng == 0) so[tt * 32 + c] = y; }
    }
    __syncthreads();
    if (stt < ns) {
      const size_t row = (size_t)(q.row0 + t0 + stt);
      *(unsigned*)(PROJ + row * LD1 + D_Z + h * 64 + pg * 32 + skc * 2) =
          pack2(so[stt * 32 + skc * 2] * siluf_(lo16(zc0)), so[stt * 32 + skc * 2 + 1] * siluf_(hi16(zc0)));
    }
    if (stt + 16 < ns) {
      const size_t row = (size_t)(q.row0 + t0 + stt + 16);
      *(unsigned*)(PROJ + row * LD1 + D_Z + h * 64 + pg * 32 + skc * 2) =
          pack2(so[(stt + 16) * 32 + skc * 2] * siluf_(lo16(zc1)), so[(stt + 16) * 32 + skc * 2 + 1] * siluf_(hi16(zc1)));
    }
  }
#undef SSD_PREFETCH
#undef SSD_PF1
#undef SSD_ST1
  f32x4* dst = (f32x4*)(p->out + (q.sample ? O_SSSD : O_PSSD) + ((size_t)(q.b * 16 + h) * 64 + pg * 32 + c) * 128 + ng * 16);
#pragma unroll
  for (int u = 0; u < 4; ++u) dst[u] = (f32x4){S[2 * u].x, S[2 * u].y, S[2 * u + 1].x, S[2 * u + 1].y};
}

__device__ void scan1_phase(KP p, char* smem) {
  const int NL = 288, NS = 4096 + 512;
  const int G = (int)gridDim.x, b = (int)blockIdx.x;
  int next_long = b;
  int cur = 0, batch_end = 0;
  for (;;) {
    int t;
    if (next_long < NL) { t = next_long; next_long += G; }
    else {
      if (cur >= batch_end) {
        const int base = next_task(p->ctr + 1, smem, 8);
        if (base >= NS) break;
        cur = base; batch_end = min(base + 8, NS);
      }
      t = NL + cur++;
    }
    int is_lru, sq, a1, a2 = 0;
    if (t < 32) { is_lru = 1; sq = t >> 2; a1 = t & 3; }
    else if (t < 288) { t -= 32; is_lru = 0; sq = t >> 5; a1 = (t >> 1) & 15; a2 = t & 1; }
    else if (t < 288 + 4096) { t -= 288; is_lru = 0; sq = 8 + (t >> 5); a1 = (t >> 1) & 15; a2 = t & 1; }
    else { t -= 288 + 4096; is_lru = 1; sq = 8 + (t >> 2); a1 = t & 3; }
    if (is_lru) lru_task(p, sq, a1); else ssd_task(p, sq, a1, a2, smem);
  }
}

__device__ void ssd_norm_phase(KP p) {
  const int lane = threadIdx.x & 63, wid = threadIdx.x >> 6;
  const int nw = gridDim.x * 4;
  const float* nwt = p->in[I_SNW];
  for (int it = blockIdx.x * 4 + wid; it < MROWS * 2; it += nw) {
    const size_t row = it >> 1; const int g = it & 1;
    bf16_t* po = p->PROJ + row * LD1 + D_Z + g * 512 + lane * 8;
    const uint4 u = *(const uint4*)po;
    float v[8] = {lo16(u.x), hi16(u.x), lo16(u.y), hi16(u.y), lo16(u.z), hi16(u.z), lo16(u.w), hi16(u.w)};
    float ss = 0.f;
#pragma unroll
    for (int j = 0; j < 8; ++j) ss += v[j] * v[j];
    ss = wave_sum(ss);
    const float rs = rsqrtf(ss * (1.f / 512.f) + 1e-5f);
    const float* w = nwt + g * 512 + lane * 8;
    uint4 r;
    r.x = pack2(v[0] * rs * w[0], v[1] * rs * w[1]); r.y = pack2(v[2] * rs * w[2], v[3] * rs * w[3]);
    r.z = pack2(v[4] * rs * w[4], v[5] * rs * w[5]); r.w = pack2(v[6] * rs * w[6], v[7] * rs * w[7]);
    *(uint4*)po = r;
  }
}

#define XB_TMO      128
#define XB_XCNT(j)  (256  + 64 * (j))
#define XB_XSUB(j)  (1280 + 64 * (j))
#define XB_XGEN(j)  (2304 + 64 * (j))
#define XB_TOP      3328
#define XB_TOPGEN   3392
#define XCD_BAR_WORDS 3456
#define XB_SPIN_CAP (1u << 18)
__device__ __forceinline__ unsigned xb_ld(unsigned* p)              { return __hip_atomic_load(p, __ATOMIC_RELAXED, __HIP_MEMORY_SCOPE_AGENT); }
__device__ __forceinline__ unsigned xb_add(unsigned* p, unsigned v) { return __hip_atomic_fetch_add(p, v, __ATOMIC_RELAXED, __HIP_MEMORY_SCOPE_AGENT); }
__device__ __forceinline__ unsigned xb_xcc_id() { return (unsigned)__builtin_amdgcn_s_getreg((3 << 11) | 20) & 0xFu; }
#define XB_SPIN(cond, bar) do { unsigned _sp = 0; while (cond) { __builtin_amdgcn_s_sleep(1); \
    if ((++_sp & 255u) == 0u) { if (xb_ld(&(bar)[XB_TMO])) break; if (_sp > XB_SPIN_CAP) { atomicAdd(&(bar)[XB_TMO], 1u); break; } } } } while (0)

__device__ __forceinline__ void xcd_barrier(unsigned* bar, unsigned x, unsigned nloc, unsigned nx) {
  asm volatile("s_waitcnt vmcnt(0)" ::: "memory");
  __syncthreads();
  if (threadIdx.x == 0) {
    __builtin_amdgcn_s_waitcnt(0);
    const unsigned old = xb_add(&bar[XB_XSUB(x)], 1u);
    const unsigned gen = old / nloc;
    if (old + 1u == (gen + 1u) * nloc) {
      __builtin_amdgcn_fence(__ATOMIC_RELEASE, "agent");
      asm volatile("s_waitcnt vmcnt(0)" ::: "memory");
      const unsigned og = xb_add(&bar[XB_TOP], 1u);
      const unsigned tg = og / nx;
      if (og + 1u == (tg + 1u) * nx) xb_add(&bar[XB_TOPGEN], 1u);
      else XB_SPIN(xb_ld(&bar[XB_TOPGEN]) == tg, bar);
      __builtin_amdgcn_fence(__ATOMIC_ACQUIRE, "agent");
      xb_add(&bar[XB_XGEN(x)], 1u);
      asm volatile("s_waitcnt vmcnt(0)" ::: "memory");
    } else {
      XB_SPIN(xb_ld(&bar[XB_XGEN(x)]) == gen, bar);
      __builtin_amdgcn_fence(__ATOMIC_ACQUIRE, "agent");
      asm volatile("s_waitcnt vmcnt(0)" ::: "memory");
    }
  }
  __syncthreads();
}

constexpr int N_PHASES = 21;
#ifndef PH_MASK
#define PH_MASK 0xffffffffu
#endif
#define PH_ON(k) (((PH_MASK) >> (k)) & 1u)

template <int PH>
__device__ __forceinline__ void run_phase(KP p, char* smem, const Sched sc) {
  float* X = p->out;
  switch (PH) {
    case 0: if (PH_ON(0)) {
      if (blockIdx.x == 0 && threadIdx.x == 0) { p->ctr[0] = 0u; p->ctr[1] = 0u; p->ctr[2] = 0u; p->ctr[3] = 0u; }
      int rot = 0;
      conv_wt(p->in[I_WIN0], nullptr, LD0, 1024, LD0, p->Win0t, 0, smem, rot);
      conv_wt(p->in[I_WOUT0], nullptr, 1024, 2048, 1024, p->Wout0t, 0, smem, rot);
      conv_wt(p->in[I_WIN1], nullptr, LD1, 1024, LD1, p->Win1t, 0, smem, rot);
      conv_wt(p->in[I_WOUT1], nullptr, 1024, 2048, 1024, p->Wout1t, 0, smem, rot);
      conv_wt(p->in[I_WG], p->in[I_WU], DFF, 1024, 2 * DFF, p->Wgu0, 1, smem, rot);
      conv_wt(p->in[I_WG] + (size_t)1024 * DFF, p->in[I_WU] + (size_t)1024 * DFF, DFF, 1024, 2 * DFF, p->Wgu1, 1, smem, rot);
      conv_wt(p->in[I_WD], nullptr, 1024, DFF, 1024, p->Wdn0, 0, smem, rot);
      conv_wt(p->in[I_WD] + (size_t)DFF * 1024, nullptr, 1024, DFF, 1024, p->Wdn1, 0, smem, rot);
      conv_wt(p->in[I_W2], nullptr, 1024, 64, 1024, p->w2t, 0, smem, rot);
      conv_wt(p->in[I_A2], nullptr, 1024, 64, 1024, p->a2t, 0, smem, rot);
      conv_wt(p->in[I_G2], nullptr, 1024, 128, 1024, p->g2t, 0, smem, rot);
#pragma unroll 1
      for (int blk = 0; blk < 8; ++blk)
        conv_wt(p->in[I_LWR] + blk * 16384, p->in[I_LWI] + blk * 16384, 128, 128, 256, p->Wri + blk * 32768, 1, smem, rot);
      rmsnorm_phase(p->in[I_XP], p->in[I_XS], p->in[I_GMIX], p->H);
    } break;
    case 1: if (PH_ON(1)) {
      GemmArgs g{p->H, p->H, p->Win0t, 1024, 1024, 1 << 30, MROWS, LD0, 1024};
      gemm_run_big<3>(g, EpiBf16{p->PROJ, LD0, LD0}, smem, sc);
    } break;
    case 2: if (PH_ON(2)) prep0_phase(p); break;
    case 3: if (PH_ON(3)) {
      GemmArgs g0{p->L, p->L, p->w2t, 256, 256, 1 << 30, MROWS, 1024, 64};
      gemm_run(g0, EpiLora<0>{p->EW, p->in[I_W0]}, smem, sc);
      GemmArgs g1{p->L + 64, p->L + 64, p->a2t, 256, 256, 1 << 30, MROWS, 1024, 64};
      gemm_run(g1, EpiLora<1>{p->AA, p->in[I_A0]}, smem, sc, 8);
      GemmArgs g2{p->L + 128, p->L + 128, p->g2t, 256, 256, 1 << 30, MROWS, 1024, 128};
      gemm_run(g2, EpiLora<2>{p->GG, nullptr}, smem, sc, 16);
    } break;
    case 4: if (PH_ON(4)) {
      scan0_phase(p, smem); } break;
    case 5: if (PH_ON(5)) gla_norm_phase(p); break;
    case 6: if (PH_ON(6)) {
      GemmArgs g{p->PROJ + C_V, p->PROJ + C_R, p->Wout0t, LD0, LD0, 1024, MROWS, 1024, 2048};
      gemm_run_272(g, p->in[I_XP], p->in[I_XS], X, smem, sc);
    } break;
    case 7: if (PH_ON(7)) rmsnorm_phase(X, X + (size_t)RP * 1024, p->in[I_GFFN], p->H); break;
    case 8: if (PH_ON(8)) {
      GemmArgs g{p->H, p->H, p->Wgu0, 1024, 1024, 1 << 30, MROWS, 2 * DFF, 1024};
#ifdef GVAR
      gemm_run_big<GVAR>(g, EpiGateUp{p->PROJ}, smem, sc);
#endif
      gemm_run_big<3>(g, EpiGateUp{p->PROJ}, smem, sc);
    } break;
    case 9: if (PH_ON(9)) {
      GemmArgs g{p->PROJ, p->PROJ, p->Wdn0, DFF, DFF, 1 << 30, MROWS, 1024, DFF};
      gemm_run_272(g, X, X + (size_t)RP * 1024, X, smem, sc);
    } break;
    case 10: if (PH_ON(10)) rmsnorm_phase(X, X + (size_t)RP * 1024, p->in[I_GMIX] + 1024, p->H); break;
    case 11: if (PH_ON(11)) {
      GemmArgs g{p->H, p->H, p->Win1t, 1024, 1024, 1 << 30, MROWS, LD1, 1024};
      gemm_run_big<3>(g, EpiBf16{p->PROJ, LD1, LD1}, smem, sc);
    } break;
    case 12: if (PH_ON(12)) prep1_phase(p); break;
    case 13: if (PH_ON(13)) {
#pragma unroll 1
      for (int blk = 0; blk < 8; ++blk) {
        GemmArgs g{p->XC + blk * 128, p->XC + blk * 128, p->Wri + blk * 32768, 1024, 1024, 1 << 30, MROWS, 256, 128};
        gemm_run(g, EpiLruGate{p->PROJ, p->GX, p->XC, p->in[I_LBR], p->in[I_LBI], p->in[I_LAMBDA], blk}, smem, sc, blk * 34);
      }
    } break;
    case 14: if (PH_ON(14)) {
      scan1_phase(p, smem); } break;
    case 15: if (PH_ON(15)) ssd_norm_phase(p); break;
    case 16: if (PH_ON(16)) {
      GemmArgs g{p->PROJ + D_GATE, p->PROJ + D_Z, p->Wout1t, LD1, LD1, 1024, MROWS, 1024, 2048};
      gemm_run_272(g, X, X + (size_t)RP * 1024, X, smem, sc);
    } break;
    case 17: if (PH_ON(17)) rmsnorm_phase(X, X + (size_t)RP * 1024, p->in[I_GFFN] + 1024, p->H); break;
    case 18: if (PH_ON(18)) {
      GemmArgs g{p->H, p->H, p->Wgu1, 1024, 1024, 1 << 30, MROWS, 2 * DFF, 1024};
      gemm_run_big<3>(g, EpiGateUp{p->PROJ}, smem, sc);
    } break;
    case 19: if (PH_ON(19)) {
      GemmArgs g{p->PROJ, p->PROJ, p->Wdn1, DFF, DFF, 1 << 30, MROWS, 1024, DFF};
      gemm_run_272(g, X, X + (size_t)RP * 1024, X, smem, sc);
    } break;
    case 20: if (PH_ON(20)) final_norm_phase(X, p->in[I_GFINAL]); break;
    default: break;
  }
}

struct XB { unsigned* bar; unsigned x, nloc, nx, rank, xidx; };

template <int PH>
__device__ __forceinline__ void phase_step(char* smem, cg::grid_group& grid, XB& xb) {
  KP p = (KP)__builtin_amdgcn_kernarg_segment_ptr();
  asm volatile("" : "+s"(p));
  {
    Sched sc; sc.xidx = (int)xb.xidx; sc.nx = (int)xb.nx; sc.rank = (int)xb.rank; sc.nloc = (int)xb.nloc;
    run_phase<PH>(p, smem, sc);
  }
  if (PH == 0) {
    grid.sync();
    unsigned nloc = 1u, nx = 0u, xi = 0u;
#pragma unroll
    for (unsigned j = 0; j < 16; ++j) {
      const unsigned c = xb_ld(&xb.bar[XB_XCNT(j)]);
      nx += (c > 0u) ? 1u : 0u;
      xi += (c > 0u && j < xb.x) ? 1u : 0u;
      nloc = (j == xb.x) ? c : nloc;
    }
    xb.xidx = (unsigned)__builtin_amdgcn_readfirstlane((int)xi);
    xb.nloc = (unsigned)__builtin_amdgcn_readfirstlane((int)(nloc > 0u ? nloc : 1u));
    xb.nx = (unsigned)__builtin_amdgcn_readfirstlane((int)(nx > 0u ? nx : 1u));
  } else if (PH + 1 < N_PHASES) {
    xcd_barrier(xb.bar, xb.x, xb.nloc, xb.nx);
#ifdef EXTRA_SYNC
    xcd_barrier(xb.bar, xb.x, xb.nloc, xb.nx); xcd_barrier(xb.bar, xb.x, xb.nloc, xb.nx);
#endif
  }
}

__global__ void __launch_bounds__(256, 2) mk_forward(Params pdummy) {
  __shared__ __attribute__((aligned(16))) char smem[65536];
  cg::grid_group grid = cg::this_grid();
  XB xb;
  {
    KP p = (KP)__builtin_amdgcn_kernarg_segment_ptr();
    xb.bar = p->bar; xb.x = xb_xcc_id(); xb.nloc = 1u; xb.nx = 1u; xb.xidx = 0u;
    unsigned rk = 0u;
    if (threadIdx.x == 0) rk = xb_add(&xb.bar[XB_XCNT(xb.x)], 1u);
    xb.rank = (unsigned)__builtin_amdgcn_readfirstlane((int)rk);
    {
      unsigned* sh = (unsigned*)(smem + 65028);
      if (threadIdx.x == 0) *sh = rk;
      __syncthreads();
      xb.rank = (unsigned)__builtin_amdgcn_readfirstlane((int)*sh);
      __syncthreads();
    }
  }
  phase_step<0>(smem, grid, xb);   phase_step<1>(smem, grid, xb);   phase_step<2>(smem, grid, xb);
  phase_step<3>(smem, grid, xb);   phase_step<4>(smem, grid, xb);   phase_step<5>(smem, grid, xb);
  phase_step<6>(smem, grid, xb);   phase_step<7>(smem, grid, xb);   phase_step<8>(smem, grid, xb);
  phase_step<9>(smem, grid, xb);   phase_step<10>(smem, grid, xb);  phase_step<11>(smem, grid, xb);
  phase_step<12>(smem, grid, xb);  phase_step<13>(smem, grid, xb);  phase_step<14>(smem, grid, xb);
  phase_step<15>(smem, grid, xb);  phase_step<16>(smem, grid, xb);  phase_step<17>(smem, grid, xb);
  phase_step<18>(smem, grid, xb);  phase_step<19>(smem, grid, xb);  phase_step<20>(smem, grid, xb);
}

#ifndef MK_SPLIT
#define MK_SPLIT 0
#endif

extern "C" void kernel_launch(void* const* d_in, const int* in_sizes, int n_in, void* d_out, int out_size, void* d_ws,
                              size_t ws_size, hipStream_t stream) {
  static int grid_blocks = 0;
  if (!grid_blocks) {
    int dev = 0, cus = 0, per_cu = 0;
    hipGetDevice(&dev);
    hipDeviceGetAttribute(&cus, hipDeviceAttributeMultiprocessorCount, dev);
    hipOccupancyMaxActiveBlocksPerMultiprocessor(&per_cu, mk_forward, 256, 0);
    if (per_cu > 2) per_cu = 2;
    grid_blocks = cus * per_cu;
  }
  Params p{};
  for (int i = 0; i < N_IN; ++i) p.in[i] = (const float*)d_in[i];
  p.out = (float*)d_out;
  char* w = (char*)d_ws;
  size_t off = 0;
  auto take = [&](size_t bytes) { char* r = w + off; off += (bytes + 255) & ~(size_t)255; return r; };
  p.ctr = (unsigned*)take(256);
  p.bar = (unsigned*)take(XCD_BAR_WORDS * 4);
  p.Win0t = (bf16_t*)take((size_t)LD0 * 1024 * 2);
  p.Wout0t = (bf16_t*)take((size_t)1024 * 2048 * 2);
  p.Win1t = (bf16_t*)take((size_t)LD1 * 1024 * 2);
  p.Wout1t = (bf16_t*)take((size_t)1024 * 2048 * 2);
  p.Wgu0 = (bf16_t*)take((size_t)2 * DFF * 1024 * 2);
  p.Wgu1 = (bf16_t*)take((size_t)2 * DFF * 1024 * 2);
  p.Wdn0 = (bf16_t*)take((size_t)1024 * DFF * 2);
  p.Wdn1 = (bf16_t*)take((size_t)1024 * DFF * 2);
  p.w2t = (bf16_t*)take((size_t)1024 * 64 * 2);
  p.a2t = (bf16_t*)take((size_t)1024 * 64 * 2);
  p.g2t = (bf16_t*)take((size_t)1024 * 128 * 2);
  p.Wri = (bf16_t*)take((size_t)8 * 256 * 128 * 2);
  p.PROJ = (bf16_t*)take((size_t)MROWS * LD0 * 2);
  p.H = (bf16_t*)take((size_t)MROWS * 1024 * 2);
  p.GG = p.H;
  p.XC = p.H;
  const size_t off_extra = off;
  p.L = (bf16_t*)take((size_t)MROWS * 256 * 2);
  p.LA = (bf16_t*)take((size_t)MROWS * 512 * 2);
  size_t end0 = off;
  off = off_extra;
  p.GX = (bf16_t*)take((size_t)MROWS * 1024 * 2);
  p.DT = (float*)take((size_t)MROWS * 16 * 4);
  size_t end1 = off;
  p.XBC = p.PROJ + (size_t)MROWS * LD1 + 128;
  p.EW = (bf16_t*)((float*)d_out + O_SLRU);
  p.AA = p.EW + (size_t)MROWS * 1024;
  size_t need = end0 > end1 ? end0 : end1;
  if (need > ws_size || (size_t)out_size < O_END) {
    fprintf(stderr, "workspace too small: need %zu have %zu (out %d)\n", need, ws_size, out_size);
    return;
  }
  hipMemsetAsync(p.bar, 0, XCD_BAR_WORDS * 4, stream);
  p.ph_begin = 0; p.ph_end = N_PHASES;
#ifndef REP_LONG
#define REP_LONG 1
#endif
#ifndef REP_SHORT
#define REP_SHORT 1
#endif
  p.rep_long = REP_LONG; p.rep_short = REP_SHORT;
  void* args[] = {&p};
  hipError_t e = hipLaunchCooperativeKernel((void*)mk_forward, dim3(grid_blocks), dim3(256), args, 0, stream);
  if (e != hipSuccess) fprintf(stderr, "cooperative launch failed: %s (grid %d)\n", hipGetErrorString(e), grid_blocks);
}
```

```cpp
#include <hip/hip_runtime.h>
#include <hip/hip_cooperative_groups.h>
#include <cstdio>
namespace cg = cooperative_groups;

typedef unsigned short bf16_t;
typedef short bf16x8 __attribute__((ext_vector_type(8)));
typedef float f32x4 __attribute__((ext_vector_type(4)));

constexpr int DM = 1024;
constexpr int RP = 16384;
constexpr int MROWS = 17408;
constexpr int NSEQ = 136;
constexpr int LD0 = 6416, LD1 = 4624, DFF = 2816;
constexpr int C_Q = 0, C_K = 512, C_V = 1024, C_AL = 2048, C_OG = 2064;
constexpr int RW0 = 3088;
constexpr int C_R = RW0, C_KR = RW0 + 1024, C_VR = RW0 + 2048, C_LORA = RW0 + 3072;
constexpr int D_GATE = 0, D_XBR = 1024, D_Z = 2048, D_XBC = 3072, D_DT = 4608;

constexpr size_t O_Y = 0;
constexpr size_t O_PGLA = (size_t)MROWS * 1024;
constexpr size_t O_PRWKV = O_PGLA + 8ull * 4 * 128 * 256;
constexpr size_t O_PSHIFT = O_PRWKV + 8ull * 16 * 64 * 64;
constexpr size_t O_PLRU = O_PSHIFT + 8ull * 3328;
constexpr size_t O_PLRUC = O_PLRU + 8ull * 1024;
constexpr size_t O_PSSD = O_PLRUC + 8ull * 3 * 1024;
constexpr size_t O_PSSDC = O_PSSD + 8ull * 16 * 64 * 128;
constexpr size_t O_SGLA = O_PSSDC + 8ull * 3 * 1536;
constexpr size_t O_SRWKV = O_SGLA + 128ull * 4 * 128 * 256;
constexpr size_t O_SSHIFT = O_SRWKV + 128ull * 16 * 64 * 64;
constexpr size_t O_SLRU = O_SSHIFT + 128ull * 3328;
constexpr size_t O_SLRUC = O_SLRU + 128ull * 1024;
constexpr size_t O_SSSD = O_SLRUC + 128ull * 3 * 1024;
constexpr size_t O_SSSDC = O_SSSD + 128ull * 16 * 64 * 128;
constexpr size_t O_END = O_SSSDC + 128ull * 3 * 1536;

enum {
  I_XP = 0, I_XS, I_SGLA, I_SRWKV, I_SSHIFT, I_SLRU, I_SLRUC, I_SSSD, I_SSSDC,
  I_WIN0, I_GLA_WA2, I_GLA_BA, I_GLA_GN, I_MU, I_W0, I_W2, I_A0, I_A2, I_G2, I_KK, I_KA, I_RK, I_LNW, I_LNB, I_WOUT0,
  I_WIN1, I_LCW, I_LCB, I_LWR, I_LBR, I_LWI, I_LBI, I_LAMBDA, I_SCW, I_SCB, I_DTB, I_ALOG, I_SD, I_SNW, I_WOUT1,
  I_GMIX, I_GFFN, I_WG, I_WU, I_WD, I_GFINAL, N_IN
};

struct Params {
  const float* in[N_IN];
  float* out;
  bf16_t *Win0t, *Wout0t, *Win1t, *Wout1t, *Wgu0, *Wgu1, *Wdn0, *Wdn1, *w2t, *a2t, *g2t, *Wri;
  bf16_t *H, *PROJ, *L, *LA, *GG, *EW, *AA, *XC, *XBC, *GX;
  float* DT;
  unsigned* ctr;
  unsigned* bar;
  int ph_begin, ph_end;
  int rep_long, rep_short;
};

typedef const Params __attribute__((address_space(4)))* KP;

__device__ __forceinline__ float bf2f(bf16_t v) { return __uint_as_float(((unsigned)v) << 16); }
__device__ __forceinline__ bf16_t f2bf(float f) {
  unsigned u = __float_as_uint(f);
  u += 0x7fffu + ((u >> 16) & 1u);
  return (bf16_t)(u >> 16);
}
__device__ __forceinline__ float bf2f(unsigned v) { return __uint_as_float(v << 16); }
__device__ __forceinline__ unsigned pack2(float a, float b) { return (unsigned)f2bf(a) | ((unsigned)f2bf(b) << 16); }
__device__ __forceinline__ float lo16(unsigned u) { return __uint_as_float(u << 16); }
__device__ __forceinline__ float hi16(unsigned u) { return __uint_as_float(u & 0xffff0000u); }
__device__ __forceinline__ float sigmoidf_(float x) { return 1.f / (1.f + __expf(-x)); }
__device__ __forceinline__ float softplusf_(float x) { return fmaxf(x, 0.f) + log1pf(__expf(-fabsf(x))); }
__device__ __forceinline__ float siluf_(float x) { return x * sigmoidf_(x); }
__device__ __forceinline__ float geluf_(float x) {
  float u = 0.7978845608028654f * (x + 0.044715f * x * x * x);
  return 0.5f * x * (1.f + tanhf(u));
}
__device__ __forceinline__ float wave_sum(float v) {
  v += __shfl_xor(v, 32); v += __shfl_xor(v, 16); v += __shfl_xor(v, 8);
  v += __shfl_xor(v, 4); v += __shfl_xor(v, 2); v += __shfl_xor(v, 1);
  return v;
}

struct Seq { int row0, T, b, sample; };
__device__ __forceinline__ Seq get_seq(int s) {
  Seq q;
  if (s < 8) { q.row0 = s * 2048; q.T = 2048; q.b = s; q.sample = 0; }
  else { q.b = s - 8; q.row0 = RP + q.b * 8; q.T = 8; q.sample = 1; }
  return q;
}

struct Sched { int xidx, nx, rank, nloc; };
struct GemmArgs { const bf16_t* A1; const bf16_t* A2; const bf16_t* Bt; int lda1, lda2, ksplit, M, N, K; };

template <class Epi>
__device__ __forceinline__ void gemm_run(const GemmArgs g, const Epi epi, char* smem, const Sched sc, int rot = 0) {
  const int tid = threadIdx.x, lane = tid & 63, wid = tid >> 6;
  const int wm = wid >> 1, wn = wid & 1, fr = lane & 15, fq = lane >> 4;
  const int ntn = (g.N + 127) >> 7, nt = (g.M >> 7) * ntn, nk = g.K >> 6;
  const int lr = tid >> 3, lc = tid & 7;
  bf16_t* sbase = (bf16_t*)smem;
  const int ntm = g.M >> 7;
  const int cq = nt / sc.nx, cr = nt - cq * sc.nx;
  const int cnt = sc.xidx < cr ? cq + 1 : cq;
  const int cstart = sc.xidx < cr ? sc.xidx * (cq + 1) : cr * (cq + 1) + (sc.xidx - cr) * cq;
  const int rk = (sc.rank + rot) % sc.nloc;
  int nfull = cnt, rem = 0, S = 1;
  if (Epi::SPLITK) {
    const int r_ = cnt % sc.nloc;
    if (r_ > 0 && 2 * r_ <= sc.nloc) { rem = r_; nfull = cnt - r_; S = min(sc.nloc / r_, nk); }
  }
  const int nitems = (nfull - rk + sc.nloc - 1) / sc.nloc + ((rem > 0 && rk < rem * S) ? 1 : 0);
  for (int it = 0; it < nitems; ++it) {
    int qi = rk + it * sc.nloc, k0 = 0, k1 = nk;
    bool split = false;
    if (qi >= nfull) { qi = nfull + rk / S; const int part = rk - (rk / S) * S; k0 = part * nk / S; k1 = (part + 1) * nk / S; split = true; }
    const int L = cstart + qi;
    const int nig = 8 * ntn, gid = L / nig, fm = gid * 8, gsz = min(ntm - fm, 8), wi = L - gid * nig;
    const int tm = fm + wi % gsz, tn = wi / gsz;
    f32x4 acc[4][4];
#pragma unroll
    for (int mi = 0; mi < 4; ++mi)
#pragma unroll
      for (int ni = 0; ni < 4; ++ni) acc[mi][ni] = (f32x4){0.f, 0.f, 0.f, 0.f};
    uint4 ra00, ra01, ra02, ra03, rb00, rb01, rb02, rb03, ra10, ra11, ra12, ra13, rb10, rb11, rb12, rb13;
#define GL1(KT, RA, RB, P)                                                                          \
      { const int r_ = lr + 32 * (P);                                                               \
        RA = *(const uint4*)(Ab_ + (size_t)(tm * 128 + r_) * lda_ + kk_ + lc * 8);                  \
        int n_ = tn * 128 + r_; n_ = n_ < g.N ? n_ : g.N - 1;                                       \
        RB = *(const uint4*)(g.Bt + (size_t)n_ * g.K + ((KT) << 6) + lc * 8); }
#define GLOAD(KT, S)                                                                                \
    {                                                                                               \
      int kk_ = (KT) << 6; const bf16_t* Ab_ = g.A1; int lda_ = g.lda1;                             \
      if (kk_ >= g.ksplit) { Ab_ = g.A2; lda_ = g.lda2; kk_ -= g.ksplit; }                          \
      GL1(KT, ra##S##0, rb##S##0, 0) GL1(KT, ra##S##1, rb##S##1, 1)                                 \
      GL1(KT, ra##S##2, rb##S##2, 2) GL1(KT, ra##S##3, rb##S##3, 3)                                 \
    }
#define SS1(RA, RB, P)                                                                              \
      { const int r_ = lr + 32 * (P);                                                               \
        const int off_ = r_ * 64 + ((lc ^ ((r_ >> 1) & 7)) << 3);                                   \
        *(uint4*)(sa_ + off_) = RA; *(uint4*)(sb_ + off_) = RB; }
#define SSTORE(BUF, S)                                                                              \
    {                                                                                               \
      bf16_t* sa_ = sbase + (BUF) * 16384; bf16_t* sb_ = sa_ + 8192;                                \
      SS1(ra##S##0, rb##S##0, 0) SS1(ra##S##1, rb##S##1, 1) SS1(ra##S##2, rb##S##2, 2) SS1(ra##S##3, rb##S##3, 3) \
    }
#define COMPUTE(BUF)                                                                                \
    {                                                                                               \
      const bf16_t* sa = sbase + (BUF) * 16384; const bf16_t* sb = sa + 8192;                       \
      _Pragma("unroll") for (int ks = 0; ks < 2; ++ks) {                                            \
        bf16x8 af[4], bfr[4];                                                                       \
        const int ch = ks * 4 + fq;                                                                 \
        _Pragma("unroll") for (int mi = 0; mi < 4; ++mi) {                                          \
          const int r = wm * 64 + mi * 16 + fr;                                                     \
          af[mi] = *(const bf16x8*)(sa + r * 64 + ((ch ^ ((r >> 1) & 7)) << 3));                    \
        }                                                                                           \
        _Pragma("unroll") for (int ni = 0; ni < 4; ++ni) {                                          \
          const int r = wn * 64 + ni * 16 + fr;                                                     \
          bfr[ni] = *(const bf16x8*)(sb + r * 64 + ((ch ^ ((r >> 1) & 7)) << 3));                   \
        }                                                                                           \
        _Pragma("unroll") for (int mi = 0; mi < 4; ++mi)                                            \
          _Pragma("unroll") for (int ni = 0; ni < 4; ++ni)                                          \
            acc[mi][ni] = __builtin_amdgcn_mfma_f32_16x16x32_bf16(bfr[ni], af[mi], acc[mi][ni], 0, 0, 0); \
      }                                                                                             \
    }
    __syncthreads();
    GLOAD(k0, 0);
    GLOAD(min(k0 + 1, k1 - 1), 1);
    SSTORE(0, 0);
    __syncthreads();
    int kt = k0;
    for (; kt + 1 < k1; kt += 2) {
      GLOAD(min(kt + 2, k1 - 1), 0);
      COMPUTE(0);
      SSTORE(1, 1);
      __syncthreads();
      GLOAD(min(kt + 3, k1 - 1), 1);
      COMPUTE(1);
      if (kt + 2 < k1) SSTORE(0, 0);
      __syncthreads();
    }
    if (kt < k1) { COMPUTE(0); __syncthreads(); }
#undef GLOAD
#undef SSTORE
#undef COMPUTE
#undef GL1
#undef SS1
    epi(acc, tm * 128 + wm * 64, tn * 128 + wn * 64, fr, fq, split);
  }
}

template <int VAR, class Epi>
__device__ __forceinline__ void gemm_run_big(const GemmArgs g, const Epi epi, char* smem, const Sched sc) {
  const int tid = threadIdx.x, lane = tid & 63, wid = tid >> 6;
  const int wm = wid >> 1, wn = wid & 1, fr = lane & 15, fq = lane >> 4;
  const int ntn = (g.N + 127) >> 7, ntm = g.M >> 8, nt = ntm * ntn, nk = g.K >> 5;
  const int lr = tid >> 2, lc = tid & 3;
  bf16_t* sbase = (bf16_t*)smem;
  const int cq = nt / sc.nx, cr = nt - cq * sc.nx;
  const int cnt = sc.xidx < cr ? cq + 1 : cq;
  const int cstart = sc.xidx < cr ? sc.xidx * (cq + 1) : cr * (cq + 1) + (sc.xidx - cr) * cq;
  for (int qi = sc.rank; qi < cnt; qi += sc.nloc) {
    const int L = cstart + qi;
    const int nig = 8 * ntn, gid = L / nig, fm = gid * 8, gsz = min(ntm - fm, 8), wi = L - gid * nig;
    const int tm = fm + wi % gsz, tn = wi / gsz;
    f32x4 acc[8][4];
#pragma unroll
    for (int mi = 0; mi < 8; ++mi)
#pragma unroll
      for (int ni = 0; ni < 4; ++ni) acc[mi][ni] = (f32x4){0.f, 0.f, 0.f, 0.f};
    uint4 a00, a01, a02, a03, b00, b01, a10, a11, a12, a13, b10, b11;
    const bf16_t* Ap = g.A1 + (size_t)(tm * 256 + lr) * g.lda1 + lc * 8;
    int nb0 = tn * 128 + lr, nb1 = nb0 + 64;
    nb0 = nb0 < g.N ? nb0 : g.N - 1; nb1 = nb1 < g.N ? nb1 : g.N - 1;
    const bf16_t* Bp0 = g.Bt + (size_t)nb0 * g.K + lc * 8;
    const bf16_t* Bp1 = g.Bt + (size_t)nb1 * g.K + lc * 8;
    const size_t a64 = (size_t)64 * g.lda1;
#define BGLOAD(KT, S)                                                                          \
    { const int ko_ = (VAR == 1) ? 0 : ((KT) << 5);                                            \
      a##S##0 = *(const uint4*)(Ap + ko_);           a##S##1 = *(const uint4*)(Ap + a64 + ko_); \
      a##S##2 = *(const uint4*)(Ap + 2 * a64 + ko_); a##S##3 = *(const uint4*)(Ap + 3 * a64 + ko_); \
      b##S##0 = *(const uint4*)(Bp0 + ko_);          b##S##1 = *(const uint4*)(Bp1 + ko_); }
    const int soff = lr * 32 + ((lc ^ ((lr >> 2) & 3)) << 3);
#define BSSTORE(BUF, S)                                                                        \
    { bf16_t* sa_ = sbase + (BUF) * 12288; bf16_t* sb_ = sa_ + 8192;                           \
      *(uint4*)(sa_ + soff) = a##S##0;        *(uint4*)(sa_ + soff + 2048) = a##S##1;          \
      *(uint4*)(sa_ + soff + 4096) = a##S##2; *(uint4*)(sa_ + soff + 6144) = a##S##3;          \
      *(uint4*)(sb_ + soff) = b##S##0;        *(uint4*)(sb_ + soff + 2048) = b##S##1; }
#define BCOMPUTE(BUF)                                                                          \
    { const bf16_t* sa = sbase + (BUF) * 12288; const bf16_t* sb = sa + 8192;                  \
      bf16x8 bfr[4];                                                                           \
      _Pragma("unroll") for (int ni = 0; ni < 4; ++ni) {                                       \
        const int r = wn * 64 + ni * 16 + fr;                                                  \
        bfr[ni] = *(const bf16x8*)(sb + r * 32 + ((fq ^ ((r >> 2) & 3)) << 3));                \
      }                                                                                        \
      _Pragma("unroll") for (int mi = 0; mi < 8; ++mi) {                                       \
        const int r = wm * 128 + mi * 16 + fr;                                                 \
        const bf16x8 af = *(const bf16x8*)(sa + r * 32 + ((fq ^ ((r >> 2) & 3)) << 3));        \
        _Pragma("unroll") for (int ni = 0; ni < 4; ++ni)                                       \
          acc[mi][ni] = __builtin_amdgcn_mfma_f32_16x16x32_bf16(bfr[ni], af, acc[mi][ni], 0, 0, 0); \
      }                                                                                        \
    }
    if (VAR == 3) {
      const int csw = lc ^ ((lr >> 2) & 3);
      const bf16_t* Aq = g.A1 + (size_t)(tm * 256 + lr) * g.lda1 + csw * 8;
      const bf16_t* Bq0 = g.Bt + (size_t)nb0 * g.K + csw * 8;
      const bf16_t* Bq1 = g.Bt + (size_t)nb1 * g.K + csw * 8;
      const int loff = lr * 32 + lc * 8;
#define BGLDS(KT, BUF)                                                                                     \
      { const int ko_ = (KT) << 5; bf16_t* sa_ = sbase + (BUF) * 12288; bf16_t* sb_ = sa_ + 8192;              \
        __builtin_amdgcn_global_load_lds((const unsigned*)(Aq + ko_), (unsigned*)(sa_ + loff), 16, 0, 0);            \
        __builtin_amdgcn_global_load_lds((const unsigned*)(Aq + a64 + ko_), (unsigned*)(sa_ + loff + 2048), 16, 0, 0); \
        __builtin_amdgcn_global_load_lds((const unsigned*)(Aq + 2 * a64 + ko_), (unsigned*)(sa_ + loff + 4096), 16, 0, 0); \
        __builtin_amdgcn_global_load_lds((const unsigned*)(Aq + 3 * a64 + ko_), (unsigned*)(sa_ + loff + 6144), 16, 0, 0); \
        __builtin_amdgcn_global_load_lds((const unsigned*)(Bq0 + ko_), (unsigned*)(sb_ + loff), 16, 0, 0);           \
        __builtin_amdgcn_global_load_lds((const unsigned*)(Bq1 + ko_), (unsigned*)(sb_ + loff + 2048), 16, 0, 0); }
      __syncthreads();
      BGLDS(0, 0);
#pragma unroll 1
      for (int kt = 0; kt < nk; kt += 2) {
        asm volatile("s_waitcnt vmcnt(0)" ::: "memory");
        __syncthreads();
        if (kt + 1 < nk) BGLDS(kt + 1, 1);
        BCOMPUTE(0);
        if (kt + 1 < nk) {
          asm volatile("s_waitcnt vmcnt(0)" ::: "memory");
          __syncthreads();
          if (kt + 2 < nk) BGLDS(kt + 2, 0);
          BCOMPUTE(1);
        }
      }
      __syncthreads();
#undef BGLDS
    } else {
    __syncthreads();
    BGLOAD(0, 0);
    BGLOAD(min(1, nk - 1), 1);
    BSSTORE(0, 0);
    __syncthreads();
    int kt = 0;
    for (; kt + 1 < nk; kt += 2) {
      BGLOAD(min(kt + 2, nk - 1), 0);
      BCOMPUTE(0);
      if (VAR != 2) BSSTORE(1, 1);
      __syncthreads();
      BGLOAD(min(kt + 3, nk - 1), 1);
      BCOMPUTE(1);
      if (VAR != 2 && kt + 2 < nk) BSSTORE(0, 0);
      __syncthreads();
    }
    if (kt < nk) { BCOMPUTE(0); __syncthreads(); }
    if (VAR == 2 && g.M < 0) { BSSTORE(0, 0); BSSTORE(1, 1); }
    }
#undef BGLOAD
#undef BSSTORE
#undef BCOMPUTE
    epi(acc, tm * 256 + wm * 128, tn * 128 + wn * 64, fr, fq, false);
  }
}

__device__ __forceinline__ void gemm_run_272(const GemmArgs g, const float* srcA, const float* srcB, float* dst, char* smem, const Sched sc) {
  const int tid = threadIdx.x, lane = tid & 63, wid = tid >> 6;
  const int wm = wid >> 1, wn = wid & 1, fr = lane & 15, fq = lane >> 4;
  const int ntn = g.N >> 7, ntm = g.M / 272, nt = ntm * ntn, nk = g.K >> 5;
  const int lr = tid >> 2, lc = tid & 3;
  bf16_t* sbase = (bf16_t*)smem;
  const int cq = nt / sc.nx, cr = nt - cq * sc.nx;
  const int cnt = sc.xidx < cr ? cq + 1 : cq;
  const int cstart = sc.xidx < cr ? sc.xidx * (cq + 1) : cr * (cq + 1) + (sc.xidx - cr) * cq;
  const int mrow0 = wm * 144;
  for (int qi = sc.rank; qi < cnt; qi += sc.nloc) {
    const int L = cstart + qi;
    const int nig = 8 * ntn, gid = L / nig, fm = gid * 8, gsz = min(ntm - fm, 8), wi = L - gid * nig;
    const int tm = fm + wi % gsz, tn = wi / gsz;
    f32x4 acc[9][4];
#pragma unroll
    for (int mi = 0; mi < 9; ++mi)
#pragma unroll
      for (int ni = 0; ni < 4; ++ni) acc[mi][ni] = (f32x4){0.f, 0.f, 0.f, 0.f};
    const int csw = lc ^ ((lr >> 2) & 3);
    const size_t arow = (size_t)(tm * 272 + lr);
    const bf16_t* Bq0 = g.Bt + (size_t)(tn * 128 + lr) * g.K + csw * 8;
    const bf16_t* Bq1 = Bq0 + (size_t)64 * g.K;
    const int loff = lr * 32 + lc * 8;
#define NGLDS(KT, BUF)                                                                                         \
    { int kk_ = (KT) << 5; const bf16_t* Ab_ = g.A1; int lda_ = g.lda1;                                        \
      if (kk_ >= g.ksplit) { Ab_ = g.A2; lda_ = g.lda2; kk_ -= g.ksplit; }                                     \
      const bf16_t* Aq_ = Ab_ + arow * lda_ + csw * 8 + kk_; const size_t a64_ = (size_t)64 * lda_;            \
      bf16_t* sa_ = sbase + (BUF) * 12800; bf16_t* sb_ = sa_ + 8704;                                           \
      __builtin_amdgcn_global_load_lds((const unsigned*)(Aq_), (unsigned*)(sa_ + loff), 16, 0, 0);             \
      __builtin_amdgcn_global_load_lds((const unsigned*)(Aq_ + a64_), (unsigned*)(sa_ + loff + 2048), 16, 0, 0);     \
      __builtin_amdgcn_global_load_lds((const unsigned*)(Aq_ + 2 * a64_), (unsigned*)(sa_ + loff + 4096), 16, 0, 0); \
      __builtin_amdgcn_global_load_lds((const unsigned*)(Aq_ + 3 * a64_), (unsigned*)(sa_ + loff + 6144), 16, 0, 0); \
      if (wid == 0) __builtin_amdgcn_global_load_lds((const unsigned*)(Aq_ + 4 * a64_), (unsigned*)(sa_ + loff + 8192), 16, 0, 0); \
      __builtin_amdgcn_global_load_lds((const unsigned*)(Bq0 + ((KT) << 5)), (unsigned*)(sb_ + loff), 16, 0, 0);     \
      __builtin_amdgcn_global_load_lds((const unsigned*)(Bq1 + ((KT) << 5)), (unsigned*)(sb_ + loff + 2048), 16, 0, 0); }
#define NCOMPUTE(BUF)                                                                          \
    { const bf16_t* sa = sbase + (BUF) * 12800; const bf16_t* sb = sa + 8704;                  \
      bf16x8 bfr[4];                                                                           \
      _Pragma("unroll") for (int ni = 0; ni < 4; ++ni) {                                       \
        const int r = wn * 64 + ni * 16 + fr;                                                  \
        bfr[ni] = *(const bf16x8*)(sb + r * 32 + ((fq ^ ((r >> 2) & 3)) << 3));                \
      }                                                                                        \
      _Pragma("unroll") for (int mi = 0; mi < 9; ++mi) {                                       \
        if (mi < 8 || wm == 0) {                                                               \
          const int r = mrow0 + mi * 16 + fr;                                                  \
          const bf16x8 af = *(const bf16x8*)(sa + r * 32 + ((fq ^ ((r >> 2) & 3)) << 3));      \
          _Pragma("unroll") for (int ni = 0; ni < 4; ++ni)                                     \
            acc[mi][ni] = __builtin_amdgcn_mfma_f32_16x16x32_bf16(bfr[ni], af, acc[mi][ni], 0, 0, 0); \
        }                                                                                      \
      }                                                                                        \
    }
    __syncthreads();
    NGLDS(0, 0);
#pragma unroll 1
    for (int kt = 0; kt < nk; kt += 2) {
      asm volatile("s_waitcnt vmcnt(0)" ::: "memory");
      __syncthreads();
      if (kt + 1 < nk) NGLDS(kt + 1, 1);
      NCOMPUTE(0);
      if (kt + 1 < nk) {
        asm volatile("s_waitcnt vmcnt(0)" ::: "memory");
        __syncthreads();
        if (kt + 2 < nk) NGLDS(kt + 2, 0);
        NCOMPUTE(1);
      }
    }
    __syncthreads();
#undef NGLDS
#undef NCOMPUTE
    const int rb = tm * 272 + mrow0, cb = tn * 128 + wn * 64;
#pragma unroll
    for (int mi = 0; mi < 9; ++mi) {
      if (mi < 8 || wm == 0) {
        const int row = rb + mi * 16 + fr;
        const float* sp = row < RP ? srcA + (size_t)row * 1024 : srcB + (size_t)(row - RP) * 1024;
#pragma unroll
        for (int ni = 0; ni < 4; ++ni) {
          const int col = cb + ni * 16 + fq * 4;
          float4 x = *(const float4*)(sp + col);
          float4 o; o.x = x.x + acc[mi][ni][0]; o.y = x.y + acc[mi][ni][1]; o.z = x.z + acc[mi][ni][2]; o.w = x.w + acc[mi][ni][3];
          *(float4*)(dst + (size_t)row * 1024 + col) = o;
        }
      }
    }
  }
}

struct EpiBf16 {
  static constexpr bool SPLITK = false;
  bf16_t* O; int ld, N;
  template <int MI>
  __device__ __forceinline__ void operator()(f32x4 (&acc)[MI][4], int rb, int cb, int fr, int fq, bool) const {
#pragma unroll
    for (int mi = 0; mi < MI; ++mi) {
      const size_t row = rb + mi * 16 + fr;
#pragma unroll
      for (int ni = 0; ni < 4; ++ni) {
        const int col = cb + ni * 16 + fq * 4;
        if (col < N) {
          uint2 v; v.x = pack2(acc[mi][ni][0], acc[mi][ni][1]); v.y = pack2(acc[mi][ni][2], acc[mi][ni][3]);
          *(uint2*)(O + row * ld + col) = v;
        }
      }
    }
  }
};
template <bool SK>
struct EpiResidualT {
  static constexpr bool SPLITK = SK;
  const float* srcA; const float* srcB; float* dst;
  __device__ __forceinline__ void operator()(f32x4 (&acc)[4][4], int rb, int cb, int fr, int fq, bool split) const {
#pragma unroll
    for (int mi = 0; mi < 4; ++mi) {
      const int row = rb + mi * 16 + fr;
      const float* s = row < RP ? srcA + (size_t)row * 1024 : srcB + (size_t)(row - RP) * 1024;
#pragma unroll
      for (int ni = 0; ni < 4; ++ni) {
        const int col = cb + ni * 16 + fq * 4;
        float* d = dst + (size_t)row * 1024 + col;
        if (SK && split) {
          unsafeAtomicAdd(d + 0, acc[mi][ni][0]); unsafeAtomicAdd(d + 1, acc[mi][ni][1]);
          unsafeAtomicAdd(d + 2, acc[mi][ni][2]); unsafeAtomicAdd(d + 3, acc[mi][ni][3]);
        } else {
          float4 x = *(const float4*)(s + col);
          float4 o; o.x = x.x + acc[mi][ni][0]; o.y = x.y + acc[mi][ni][1]; o.z = x.z + acc[mi][ni][2]; o.w = x.w + acc[mi][ni][3];
          *(float4*)d = o;
        }
      }
    }
  }
};
typedef EpiResidualT<false> EpiResidual;
typedef EpiResidualT<true> EpiResidualSK;
struct EpiGateUp {
  static constexpr bool SPLITK = false;
  bf16_t* act;
  template <int MI>
  __device__ __forceinline__ void operator()(f32x4 (&acc)[MI][4], int rb, int cb, int fr, int fq, bool) const {
#pragma unroll
    for (int mi = 0; mi < MI; ++mi) {
      const size_t row = rb + mi * 16 + fr;
#pragma unroll
      for (int np = 0; np < 2; ++np) {
        const int c = ((cb + np * 32) >> 1) + fq * 4;
        float o[4];
#pragma unroll
        for (int j = 0; j < 4; ++j) o[j] = siluf_(acc[mi][2 * np][j]) * acc[mi][2 * np + 1][j];
        uint2 v; v.x = pack2(o[0], o[1]); v.y = pack2(o[2], o[3]);
        *(uint2*)(act + row * DFF + c) = v;
      }
    }
  }
};
template <int MODE>
struct EpiLora {
  static constexpr bool SPLITK = false;
  bf16_t* O; const float* bias;
  __device__ __forceinline__ void operator()(f32x4 (&acc)[4][4], int rb, int cb, int fr, int fq, bool) const {
#pragma unroll
    for (int mi = 0; mi < 4; ++mi) {
      const size_t row = rb + mi * 16 + fr;
#pragma unroll
      for (int ni = 0; ni < 4; ++ni) {
        const int col = cb + ni * 16 + fq * 4;
        float o[4];
#pragma unroll
        for (int j = 0; j < 4; ++j) {
          float a = acc[mi][ni][j];
          if (MODE == 0) { float x = bias[col + j] + a; o[j] = __expf(-softplusf_(-x) - 0.5f); }
          else if (MODE == 1) { o[j] = sigmoidf_(bias[col + j] + a); }
          else o[j] = a;
        }
        uint2 v; v.x = pack2(o[0], o[1]); v.y = pack2(o[2], o[3]);
        *(uint2*)(O + row * 1024 + col) = v;
      }
    }
  }
};
struct EpiLruGate {
  static constexpr bool SPLITK = false;
  bf16_t* PROJ; bf16_t* GX; const bf16_t* XC; const float* b_r; const float* b_i; const float* lam; int blk;
  __device__ __forceinline__ void operator()(f32x4 (&acc)[4][4], int rb, int cb, int fr, int fq, bool) const {
#pragma unroll
    for (int mi = 0; mi < 4; ++mi) {
      const size_t row = rb + mi * 16 + fr;
#pragma unroll
      for (int np = 0; np < 2; ++np) {
        const int e = blk * 128 + ((cb + np * 32) >> 1) + fq * 4;
        uint2 xu = *(const uint2*)(XC + row * 1024 + e);
        float xv[4] = {lo16(xu.x), hi16(xu.x), lo16(xu.y), hi16(xu.y)};
        float la[4], gx[4];
#pragma unroll
        for (int j = 0; j < 4; ++j) {
          float rg = sigmoidf_(acc[mi][2 * np][j] + b_r[e + j]);
          float ig = sigmoidf_(acc[mi][2 * np + 1][j] + b_i[e + j]);
          la[j] = -8.f * rg * softplusf_(-lam[e + j]);
          gx[j] = ig * xv[j];
        }
        uint2 v; v.x = pack2(la[0], la[1]); v.y = pack2(la[2], la[3]);
        *(uint2*)(PROJ + row * LD1 + D_XBR + e) = v;
        uint2 w; w.x = pack2(gx[0], gx[1]); w.y = pack2(gx[2], gx[3]);
        *(uint2*)(GX + row * 1024 + e) = w;
      }
    }
  }
};

__device__ void conv_wt(const float* src, const float* src2, int ld, int K, int Nout, bf16_t* dst, int paired,
                        char* smem, int& rot) {
  float* tile = (float*)smem;
  const int tid = threadIdx.x;
  const int ntk = K >> 6, ntn = (Nout + 63) >> 6, nt = ntk * ntn;
  const int G = (int)gridDim.x;
  const int start = (int)((blockIdx.x + G - (rot % G)) % G);
  rot += nt;
  for (int t = start; t < nt; t += G) {
    const int tk = t % ntk, tn = t / ntk;
    __syncthreads();
    {
      const int n = tn * 64 + (tid & 63);
      const float* s = src; int c = n;
      if (paired) { const int grp = n >> 5, w = n & 31; c = grp * 16 + (w & 15); s = (w < 16) ? src : src2; }
      const bool ok = n < Nout;
#pragma unroll
      for (int i = 0; i < 16; ++i) {
        const int k = (tid >> 6) + 4 * i;
        tile[k * 65 + (tid & 63)] = ok ? s[(size_t)(tk * 64 + k) * ld + c] : 0.f;
      }
    }
    __syncthreads();
    {
      const int n2 = tid >> 2, kc = (tid & 3) * 16;
      if (tn * 64 + n2 < Nout) {
        unsigned pk[8];
#pragma unroll
        for (int j = 0; j < 8; ++j) pk[j] = pack2(tile[(kc + 2 * j) * 65 + n2], tile[(kc + 2 * j + 1) * 65 + n2]);
        uint4* d = (uint4*)(dst + (size_t)(tn * 64 + n2) * K + tk * 64 + kc);
        d[0] = make_uint4(pk[0], pk[1], pk[2], pk[3]);
        d[1] = make_uint4(pk[4], pk[5], pk[6], pk[7]);
      }
    }
  }
}

__device__ void rmsnorm_phase(const float* xa, const float* xb, const float* g, bf16_t* H) {
  const int lane = threadIdx.x & 63, wid = threadIdx.x >> 6;
  const int nw = gridDim.x * 4;
  for (int row = blockIdx.x * 4 + wid; row < MROWS; row += nw) {
    const float* x = row < RP ? xa + (size_t)row * 1024 : xb + (size_t)(row - RP) * 1024;
    float4 v[4]; float ss = 0.f;
#pragma unroll
    for (int i = 0; i < 4; ++i) {
      v[i] = *(const float4*)(x + lane * 4 + 256 * i);
      ss += v[i].x * v[i].x + v[i].y * v[i].y + v[i].z * v[i].z + v[i].w * v[i].w;
    }
    ss = wave_sum(ss);
    const float rs = rsqrtf(ss * (1.f / 1024.f) + 1e-6f);
#pragma unroll
    for (int i = 0; i < 4; ++i) {
      const int c = lane * 4 + 256 * i;
      float4 gg = *(const float4*)(g + c);
      uint2 o; o.x = pack2(v[i].x * rs * gg.x, v[i].y * rs * gg.y); o.y = pack2(v[i].z * rs * gg.z, v[i].w * rs * gg.w);
      *(uint2*)(H + (size_t)row * 1024 + c) = o;
    }
  }
}
__device__ void final_norm_phase(float* x, const float* g) {
  const int lane = threadIdx.x & 63, wid = threadIdx.x >> 6;
  const int nw = gridDim.x * 4;
  for (int row = blockIdx.x * 4 + wid; row < MROWS; row += nw) {
    float* xr = x + (size_t)row * 1024;
    float4 v[4]; float ss = 0.f;
#pragma unroll
    for (int i = 0; i < 4; ++i) {
      v[i] = *(const float4*)(xr + lane * 4 + 256 * i);
      ss += v[i].x * v[i].x + v[i].y * v[i].y + v[i].z * v[i].z + v[i].w * v[i].w;
    }
    ss = wave_sum(ss);
    const float rs = rsqrtf(ss * (1.f / 1024.f) + 1e-6f);
#pragma unroll
    for (int i = 0; i < 4; ++i) {
      const int c = lane * 4 + 256 * i;
      float4 gg = *(const float4*)(g + c);
      float4 o; o.x = v[i].x * rs * gg.x; o.y = v[i].y * rs * gg.y; o.z = v[i].z * rs * gg.z; o.w = v[i].w * rs * gg.w;
      *(float4*)(xr + c) = o;
    }
  }
}

__device__ void prep0_phase(KP p) {
  const int tid = threadIdx.x;
  const int G = (int)gridDim.x;
  const float* mu = p->in[I_MU];
  const float* wa2 = p->in[I_GLA_WA2];
  const float* ba = p->in[I_GLA_BA];
  for (int row = blockIdx.x; row < MROWS; row += G) {
    int t, b, sample;
    if (row < RP) { t = row & 2047; b = row >> 11; sample = 0; } else { const int rr = row - RP; b = rr >> 3; t = rr & 7; sample = 1; }
    const bf16_t* pr = p->PROJ + (size_t)row * LD0;
    {
      const int j = tid;
      const float c = bf2f(pr[C_LORA + j]);
      float prev = 0.f;
      if (t > 0) prev = bf2f(pr[C_LORA + j - LD0]);
      else if (sample) prev = p->in[I_SSHIFT][(size_t)b * 3328 + 3072 + j];
      const float m = c + (prev - c) * mu[3072 + j];
      float val = m;
      if (j < 64) val = tanhf(m); else if (j >= 128) val = sigmoidf_(m);
      p->L[(size_t)row * 256 + j] = f2bf(val);
    }
    {
      uint4 u0 = *(const uint4*)(pr + C_AL), u1 = *(const uint4*)(pr + C_AL + 8);
      float al[16] = {lo16(u0.x), hi16(u0.x), lo16(u0.y), hi16(u0.y), lo16(u0.z), hi16(u0.z), lo16(u0.w), hi16(u0.w),
                      lo16(u1.x), hi16(u1.x), lo16(u1.y), hi16(u1.y), lo16(u1.z), hi16(u1.z), lo16(u1.w), hi16(u1.w)};
#pragma unroll
      for (int h2 = 0; h2 < 2; ++h2) {
        const int k = tid + 256 * h2;
        float a = ba[k];
#pragma unroll
        for (int i = 0; i < 16; ++i) a += al[i] * wa2[i * 512 + k];
        const float la = -softplusf_(-a) * (1.f / 16.f);
        p->LA[(size_t)row * 512 + k] = f2bf(la);
      }
    }
  }
  for (int s = blockIdx.x; s < NSEQ; s += G) {
    const Seq q = get_seq(s);
    const bf16_t* pr = p->PROJ + (size_t)(q.row0 + q.T - 1) * LD0 + RW0;
    float* o = p->out + (q.sample ? O_SSHIFT + (size_t)q.b * 3328 : O_PSHIFT + (size_t)q.b * 3328);
    for (int j = tid; j < 3328; j += 256) o[j] = bf2f(pr[j]);
  }
}

#ifndef REP_SEL
#define REP_SEL -1
#endif
__device__ __forceinline__ int next_task(unsigned* ctr, char* smem, unsigned n) {
  int* st = (int*)(smem + 65024);
  __syncthreads();
  if (threadIdx.x == 0) *st = (int)atomicAdd(ctr, n);
  __syncthreads();
  return *st;
}

typedef float f32x2 __attribute__((ext_vector_type(2)));
__device__ __forceinline__ float dpp_f(float v, const int ctrl_sel) {
  int x = __float_as_int(v), r;
  if (ctrl_sel == 0) r = __builtin_amdgcn_update_dpp(0, x, 0xB1, 0xF, 0xF, true);
  else if (ctrl_sel == 1) r = __builtin_amdgcn_update_dpp(0, x, 0x4E, 0xF, 0xF, true);
  else if (ctrl_sel == 2) r = __builtin_amdgcn_update_dpp(0, x, 0x141, 0xF, 0xF, true);
  else r = __builtin_amdgcn_update_dpp(0, x, 0x140, 0xF, 0xF, true);
  return __int_as_float(r);
}
__device__ __forceinline__ float sum4(float v) { v += dpp_f(v, 0); v += dpp_f(v, 1); return v; }
__device__ __forceinline__ float sum8(float v) { v = sum4(v); v += dpp_f(v, 2); return v; }
__device__ __forceinline__ float wave_sum3(float v) {
  v = sum8(v); v += dpp_f(v, 3);
  const float a = __int_as_float(__builtin_amdgcn_readlane(__float_as_int(v), 0));
  const float b = __int_as_float(__builtin_amdgcn_readlane(__float_as_int(v), 16));
  const float c = __int_as_float(__builtin_amdgcn_readlane(__float_as_int(v), 32));
  const float d = __int_as_float(__builtin_amdgcn_readlane(__float_as_int(v), 48));
  return (a + b) + (c + d);
}
__device__ __forceinline__ float wave_sum2(float v) {
  v = sum8(v); v += dpp_f(v, 3);
  v += __shfl_xor(v, 16); v += __shfl_xor(v, 32);
  return v;
}

static __device__ __forceinline__ void gla_task(KP p, int s, int h, int cgp, char* smem) {
  float* sq = (float*)smem; float* sk = sq + 2048; float* sea = sk + 2048; float* sv = sea + 2048; float* so = sv + 512;
  const Seq q = get_seq(s);
  const int tid = threadIdx.x, cp = tid >> 4, k8 = tid & 15;
  const int stt = tid >> 4, skc = tid & 15;
  bf16_t* PROJ = p->PROJ; const bf16_t* LA = p->LA;
  const int nrep_ = q.T > 8 ? ((REP_SEL < 0 || REP_SEL == 0) ? p->rep_long : 1) : p->rep_short;
  for (int rep_ = 0; rep_ < nrep_; ++rep_) {
  const bool last_ = rep_ == nrep_ - 1;
  f32x2 S0[4], S1[4];
  if (q.sample) {
    const float* st = p->in[I_SGLA] + ((size_t)(q.b * 4 + h) * 128 + k8 * 8) * 256 + cgp * 32 + 2 * cp;
#pragma unroll
    for (int u = 0; u < 4; ++u) {
      const f32x2 ra = *(const f32x2*)(st + (size_t)(2 * u) * 256), rb = *(const f32x2*)(st + (size_t)(2 * u + 1) * 256);
      S0[u] = (f32x2){ra.x, rb.x}; S1[u] = (f32x2){ra.y, rb.y};
    }
  } else {
#pragma unroll
    for (int u = 0; u < 4; ++u) { S0[u] = (f32x2){0.f, 0.f}; S1[u] = (f32x2){0.f, 0.f}; }
  }
  const float qs = 0.08838834764831845f;
  uint4 uq = make_uint4(0, 0, 0, 0), uk = uq, ul = uq; unsigned uv = 0;
#define GLA_PREFETCH(T0)                                                                   \
  {                                                                                        \
    const int ns_ = min(16, q.T - (T0));                                                   \
    if (stt < ns_) {                                                                       \
      const size_t row_ = (size_t)(q.row0 + (T0) + stt);                                   \
      const bf16_t* pr_ = PROJ + row_ * LD0;                                               \
      uq = *(const uint4*)(pr_ + C_Q + h * 128 + skc * 8);                                 \
      uk = *(const uint4*)(pr_ + C_K + h * 128 + skc * 8);                                 \
      ul = *(const uint4*)(LA + row_ * 512 + h * 128 + skc * 8);                           \
      uv = *(const unsigned*)(pr_ + C_V + h * 256 + cgp * 32 + skc * 2);                   \
    }                                                                                      \
  }
  GLA_PREFETCH(0);
  for (int t0 = 0; t0 < q.T; t0 += 16) {
    const int ns = min(16, q.T - t0);
    __syncthreads();
    if (stt < ns) {
      f32x4* dq = (f32x4*)(sq + stt * 128 + skc * 8); f32x4* dk = (f32x4*)(sk + stt * 128 + skc * 8); f32x4* de = (f32x4*)(sea + stt * 128 + skc * 8);
      dq[0] = (f32x4){lo16(uq.x) * qs, hi16(uq.x) * qs, lo16(uq.y) * qs, hi16(uq.y) * qs};
      dq[1] = (f32x4){lo16(uq.z) * qs, hi16(uq.z) * qs, lo16(uq.w) * qs, hi16(uq.w) * qs};
      dk[0] = (f32x4){lo16(uk.x), hi16(uk.x), lo16(uk.y), hi16(uk.y)};
      dk[1] = (f32x4){lo16(uk.z), hi16(uk.z), lo16(uk.w), hi16(uk.w)};
      de[0] = (f32x4){__expf(lo16(ul.x)), __expf(hi16(ul.x)), __expf(lo16(ul.y)), __expf(hi16(ul.y))};
      de[1] = (f32x4){__expf(lo16(ul.z)), __expf(hi16(ul.z)), __expf(lo16(ul.w)), __expf(hi16(ul.w))};
      *(f32x2*)(sv + stt * 32 + skc * 2) = (f32x2){lo16(uv), hi16(uv)};
    }
    __syncthreads();
    if (t0 + 16 < q.T) GLA_PREFETCH(t0 + 16);
    struct GlaOps { f32x2 vv; f32x4 q[2], k[2], e[2]; };
    auto gla_load = [&](const int tt, GlaOps& o) {
      o.vv = *(const f32x2*)(sv + tt * 32 + 2 * cp);
      const f32x4* q4 = (const f32x4*)(sq + tt * 128 + k8 * 8);
      const f32x4* k4 = (const f32x4*)(sk + tt * 128 + k8 * 8);
      const f32x4* e4 = (const f32x4*)(sea + tt * 128 + k8 * 8);
      o.q[0] = q4[0]; o.q[1] = q4[1]; o.k[0] = k4[0]; o.k[1] = k4[1]; o.e[0] = e4[0]; o.e[1] = e4[1];
    };
    auto gla_math = [&](const GlaOps& o, float& y0, float& y1) {
      const f32x2 v0 = (f32x2){o.vv.x, o.vv.x}, v1 = (f32x2){o.vv.y, o.vv.y};
      S0[0] = o.e[0].xy * S0[0] + o.k[0].xy * v0; S0[1] = o.e[0].zw * S0[1] + o.k[0].zw * v0;
      S0[2] = o.e[1].xy * S0[2] + o.k[1].xy * v0; S0[3] = o.e[1].zw * S0[3] + o.k[1].zw * v0;
      S1[0] = o.e[0].xy * S1[0] + o.k[0].xy * v1; S1[1] = o.e[0].zw * S1[1] + o.k[0].zw * v1;
      S1[2] = o.e[1].xy * S1[2] + o.k[1].xy * v1; S1[3] = o.e[1].zw * S1[3] + o.k[1].zw * v1;
      f32x2 a = o.q[0].xy * S0[0], b2 = o.q[0].zw * S0[1], c2 = o.q[0].xy * S1[0], d2 = o.q[0].zw * S1[1];
      a = o.q[1].xy * S0[2] + a; b2 = o.q[1].zw * S0[3] + b2; c2 = o.q[1].xy * S1[2] + c2; d2 = o.q[1].zw * S1[3] + d2;
      a += b2; c2 += d2;
      y0 = a.x + a.y; y1 = c2.x + c2.y;
    };
    {
      GlaOps ga, gb;
      gla_load(0, ga);
#pragma unroll 1
      for (int tt = 0; tt < ns; tt += 4) {
        float yp0[4], yp1[4];
#pragma unroll
        for (int u = 0; u < 4; u += 2) {
          gla_load(tt + u + 1, gb);
          __builtin_amdgcn_sched_barrier(0);
          gla_math(ga, yp0[u], yp1[u]);
          __builtin_amdgcn_sched_barrier(0);
          gla_load(min(tt + u + 2, ns - 1), ga);
          __builtin_amdgcn_sched_barrier(0);
          gla_math(gb, yp0[u + 1], yp1[u + 1]);
          __builtin_amdgcn_sched_barrier(0);
        }
#pragma unroll
        for (int u = 0; u < 4; ++u) {
          yp0[u] = sum8(yp0[u]); yp0[u] += dpp_f(yp0[u], 3);
          yp1[u] = sum8(yp1[u]); yp1[u] += dpp_f(yp1[u], 3);
        }
        if (k8 == 0) {
#pragma unroll
          for (int u = 0; u < 4; ++u) *(f32x2*)(so + (tt + u) * 32 + 2 * cp) = (f32x2){yp0[u], yp1[u]};
        }
        __builtin_amdgcn_sched_barrier(0);
      }
    }
    __syncthreads();
    if (stt < ns && last_) {
      const size_t row = (size_t)(q.row0 + t0 + stt);
      *(unsigned*)(PROJ + row * LD0 + C_V + h * 256 + cgp * 32 + skc * 2) = pack2(so[stt * 32 + skc * 2], so[stt * 32 + skc * 2 + 1]);
    }
  }
#undef GLA_PREFETCH
  float* dst = p->out + (q.sample ? O_SGLA : O_PGLA) + ((size_t)(q.b * 4 + h) * 128 + k8 * 8) * 256 + cgp * 32 + 2 * cp;
  if (last_) {
#pragma unroll
    for (int u = 0; u < 4; ++u) {
      *(f32x2*)(dst + (size_t)(2 * u) * 256) = (f32x2){S0[u].x, S1[u].x};
      *(f32x2*)(dst + (size_t)(2 * u + 1) * 256) = (f32x2){S0[u].y, S1[u].y};
    }
  }
  }

}

static __device__ __forceinline__ void rwkv_task(KP p, int s, int h, char* smem) {
  float* sr = (float*)smem; float* sw = sr + 1024; float* skp = sw + 1024; float* snk = skp + 1024; float* sb = snk + 1024;
  float* sv = sb + 1024; float* sy = sv + 1024; float* sbon = sy + 1024; float* scar = sbon + 16;
  float* sg = scar + 384 + 512;
  float* spar = scar + 384;
  const Seq q = get_seq(s);
  const int tid = threadIdx.x, lane = tid & 63, wid = tid >> 6;
  const int rp = tid >> 3, j8 = tid & 7;
  bf16_t* PROJ = p->PROJ; const bf16_t* EW = p->EW; const bf16_t* AA = p->AA; const bf16_t* GG = p->GG;
  const int nrep_ = q.T > 8 ? ((REP_SEL < 0 || REP_SEL == 1) ? p->rep_long : 1) : p->rep_short;
  for (int rep_ = 0; rep_ < nrep_; ++rep_) {
  const bool last_ = rep_ == nrep_ - 1;
  f32x2 S0[4], S1[4];
  if (q.sample) {
    const f32x4* st0 = (const f32x4*)(p->in[I_SRWKV] + ((size_t)(q.b * 16 + h) * 64 + 2 * rp) * 64 + j8 * 8);
    f32x4 v = st0[0]; S0[0] = v.xy; S0[1] = v.zw; v = st0[1]; S0[2] = v.xy; S0[3] = v.zw;
    v = st0[16]; S1[0] = v.xy; S1[1] = v.zw; v = st0[17]; S1[2] = v.xy; S1[3] = v.zw;
  } else {
#pragma unroll
    for (int u = 0; u < 4; ++u) { S0[u] = (f32x2){0.f, 0.f}; S1[u] = (f32x2){0.f, 0.f}; }
  }
  __syncthreads();
  if (tid < 192) {
    const int a = tid >> 6, j = tid & 63;
    scar[a * 64 + j] = q.sample ? p->in[I_SSHIFT][(size_t)q.b * 3328 + a * 1024 + h * 64 + j] : 0.f;
  }
  const int col = h * 64 + lane;
  if (tid < 64) {
    spar[lane] = p->in[I_MU][col]; spar[64 + lane] = p->in[I_MU][1024 + col]; spar[128 + lane] = p->in[I_MU][2048 + col];
    spar[192 + lane] = p->in[I_KK][col]; spar[256 + lane] = p->in[I_KA][col]; spar[320 + lane] = p->in[I_RK][col];
    spar[384 + lane] = p->in[I_LNW][col]; spar[448 + lane] = p->in[I_LNB][col];
  }
  unsigned xr[4], xk[4], xv[4], xe[4], xa[4], xg[4], yr = 0, yk = 0, yv = 0;
#pragma unroll
  for (int u = 0; u < 4; ++u) { xr[u] = xk[u] = xv[u] = xe[u] = xa[u] = xg[u] = 0; }
#define RWKV_PREFETCH(T0)                                                                  \
  {                                                                                        \
    const int ns_ = min(16, q.T - (T0));                                                   \
    _Pragma("unroll") for (int u = 0; u < 4; ++u) {                                        \
      const int tt_ = 4 * wid + u;                                                         \
      if (tt_ < ns_) {                                                                     \
        const size_t row_ = (size_t)(q.row0 + (T0) + tt_);                                 \
        const bf16_t* pr_ = PROJ + row_ * LD0;                                             \
        xr[u] = pr_[C_R + col]; xk[u] = pr_[C_KR + col]; xv[u] = pr_[C_VR + col];          \
        xe[u] = EW[row_ * 1024 + col]; xa[u] = AA[row_ * 1024 + col]; xg[u] = GG[row_ * 1024 + col]; \
      }                                                                                    \
    }                                                                                      \
    if (wid > 0 && 4 * wid < ns_) {                                                        \
      const bf16_t* pr_ = PROJ + (size_t)(q.row0 + (T0) + 4 * wid - 1) * LD0;              \
      yr = pr_[C_R + col]; yk = pr_[C_KR + col]; yv = pr_[C_VR + col];                     \
    }                                                                                      \
  }
  RWKV_PREFETCH(0);
  int par = 0;
  for (int t0 = 0; t0 < q.T; t0 += 16, par ^= 1) {
    const int ns = min(16, q.T - t0);
    __syncthreads();
    {
      const float mu_r = spar[lane], mu_k = spar[64 + lane], mu_v = spar[128 + lane];
      const float k_k = spar[192 + lane], k_a = spar[256 + lane], r_k = spar[320 + lane];
      float pr_r, pr_k, pr_v;
      if (wid > 0) { pr_r = bf2f(yr); pr_k = bf2f(yk); pr_v = bf2f(yv); }
      else { pr_r = scar[par * 192 + lane]; pr_k = scar[par * 192 + 64 + lane]; pr_v = scar[par * 192 + 128 + lane]; }
#pragma unroll
      for (int u = 0; u < 4; ++u) {
        const int tt = 4 * wid + u;
        const float cr = bf2f(xr[u]), ck = bf2f(xk[u]), cv = bf2f(xv[u]);
        if (tt < ns) {
          if (tt == ns - 1) { scar[(par ^ 1) * 192 + lane] = cr; scar[(par ^ 1) * 192 + 64 + lane] = ck; scar[(par ^ 1) * 192 + 128 + lane] = cv; }
          const float r = cr + (pr_r - cr) * mu_r, kr = ck + (pr_k - ck) * mu_k, vr = cv + (pr_v - cv) * mu_v;
          const float ew = bf2f(xe[u]);
          const float a = bf2f(xa[u]);
          const float w = __expf(-ew);
          const float kkr = kr * k_k;
          const float ss = wave_sum3(kkr * kkr);
          const float kk = kkr * rsqrtf(fmaxf(ss, 1e-24f));
          const float kp = kr * (1.f + (a - 1.f) * k_a);
          const float bon = wave_sum3(r * kp * r_k);
          sr[tt * 64 + lane] = r; sw[tt * 64 + lane] = w; skp[tt * 64 + lane] = kp; snk[tt * 64 + lane] = -kk;
          sb[tt * 64 + lane] = kk * a; sv[tt * 64 + lane] = vr; sg[tt * 64 + lane] = bf2f(xg[u]);
          if (lane == 0) sbon[tt] = bon;
        }
        pr_r = cr; pr_k = ck; pr_v = cv;
      }
    }
    __syncthreads();
    if (t0 + 16 < q.T) RWKV_PREFETCH(t0 + 16);
    struct RwN { f32x2 vi; f32x4 n[2]; };
    struct RwW { f32x4 w[2], b[2], k[2], r[2]; };
    auto rw_loadn = [&](const int tt, RwN& o) {
      o.vi = *(const f32x2*)(sv + tt * 64 + 2 * rp);
      const f32x4* n4 = (const f32x4*)(snk + tt * 64 + j8 * 8);
      o.n[0] = n4[0]; o.n[1] = n4[1];
    };
    auto rw_loadw = [&](const int tt, RwW& o) {
      const f32x4* w4 = (const f32x4*)(sw + tt * 64 + j8 * 8);
      const f32x4* b4 = (const f32x4*)(sb + tt * 64 + j8 * 8);
      const f32x4* k4 = (const f32x4*)(skp + tt * 64 + j8 * 8);
      const f32x4* r4 = (const f32x4*)(sr + tt * 64 + j8 * 8);
      o.w[0] = w4[0]; o.w[1] = w4[1]; o.b[0] = b4[0]; o.b[1] = b4[1];
      o.k[0] = k4[0]; o.k[1] = k4[1]; o.r[0] = r4[0]; o.r[1] = r4[1];
    };
    auto rw_sa = [&](const RwN& o, const RwW& w, float& sa0, float& sa1) {
      f32x2 a0 = S0[0] * o.n[0].xy, a0b = S0[1] * o.n[0].zw, a1 = S1[0] * o.n[0].xy, a1b = S1[1] * o.n[0].zw;
      a0 = S0[2] * o.n[1].xy + a0; a0b = S0[3] * o.n[1].zw + a0b; a1 = S1[2] * o.n[1].xy + a1; a1b = S1[3] * o.n[1].zw + a1b;
      a0 += a0b; a1 += a1b;
      sa0 = sum8(a0.x + a0.y); sa1 = sum8(a1.x + a1.y);
      const f32x2 v0 = (f32x2){o.vi.x, o.vi.x}, v1 = (f32x2){o.vi.y, o.vi.y};
      S0[0] = S0[0] * w.w[0].xy + v0 * w.k[0].xy; S0[1] = S0[1] * w.w[0].zw + v0 * w.k[0].zw;
      S0[2] = S0[2] * w.w[1].xy + v0 * w.k[1].xy; S0[3] = S0[3] * w.w[1].zw + v0 * w.k[1].zw;
      S1[0] = S1[0] * w.w[0].xy + v1 * w.k[0].xy; S1[1] = S1[1] * w.w[0].zw + v1 * w.k[0].zw;
      S1[2] = S1[2] * w.w[1].xy + v1 * w.k[1].xy; S1[3] = S1[3] * w.w[1].zw + v1 * w.k[1].zw;
    };
    auto rw_upd = [&](const RwW& o, const float sa0, const float sa1, float& y0, float& y1) {
      const f32x2 s0 = (f32x2){sa0, sa0}, s1 = (f32x2){sa1, sa1};
      S0[0] = s0 * o.b[0].xy + S0[0]; S0[1] = s0 * o.b[0].zw + S0[1]; S0[2] = s0 * o.b[1].xy + S0[2]; S0[3] = s0 * o.b[1].zw + S0[3];
      S1[0] = s1 * o.b[0].xy + S1[0]; S1[1] = s1 * o.b[0].zw + S1[1]; S1[2] = s1 * o.b[1].xy + S1[2]; S1[3] = s1 * o.b[1].zw + S1[3];
      f32x2 ya = S0[0] * o.r[0].xy, yb = S0[1] * o.r[0].zw, yc = S1[0] * o.r[0].xy, yd = S1[1] * o.r[0].zw;
      ya = S0[2] * o.r[1].xy + ya; yb = S0[3] * o.r[1].zw + yb; yc = S1[2] * o.r[1].xy + yc; yd = S1[3] * o.r[1].zw + yd;
      ya += yb; yc += yd;
      y0 = ya.x + ya.y; y1 = yc.x + yc.y;
    };
    {
      RwN na; RwW wv;
      rw_loadn(0, na);
#pragma unroll 1
      for (int tt = 0; tt < ns; tt += 4) {
        float yp0[4], yp1[4];
#pragma unroll
        for (int u = 0; u < 4; ++u) {
          rw_loadw(tt + u, wv);
          __builtin_amdgcn_sched_barrier(0);
          float sa0, sa1;
          rw_sa(na, wv, sa0, sa1);
          __builtin_amdgcn_sched_barrier(0);
          rw_loadn(min(tt + u + 1, ns - 1), na);
          __builtin_amdgcn_sched_barrier(0);
          rw_upd(wv, sa0, sa1, yp0[u], yp1[u]);
          __builtin_amdgcn_sched_barrier(0);
        }
#pragma unroll
        for (int u = 0; u < 4; ++u) { yp0[u] = sum8(yp0[u]); yp1[u] = sum8(yp1[u]); }
        if (j8 == 0) {
#pragma unroll
          for (int u = 0; u < 4; ++u) *(f32x2*)(sy + (tt + u) * 64 + 2 * rp) = (f32x2){yp0[u], yp1[u]};
        }
        __builtin_amdgcn_sched_barrier(0);
      }
    }
    __syncthreads();
#pragma unroll
    for (int u = 0; u < 4; ++u) {
      const int tt = 4 * wid + u;
      if (tt < ns) {
        const size_t row = (size_t)(q.row0 + t0 + tt);
        const float y = sy[tt * 64 + lane];
        const float s1 = wave_sum3(y), s2 = wave_sum3(y * y);
        const float mean = s1 * (1.f / 64.f);
        const float var = fmaxf(s2 * (1.f / 64.f) - mean * mean, 0.f);
        const float gn = (y - mean) * rsqrtf(var + 64e-5f) * spar[384 + lane] + spar[448 + lane];
        const float o = (gn + sbon[tt] * sv[tt * 64 + lane]) * sg[tt * 64 + lane];
        if (last_) PROJ[row * LD0 + C_R + col] = f2bf(o);
      }
    }
  }
#undef RWKV_PREFETCH
  f32x4* dst = (f32x4*)(p->out + (q.sample ? O_SRWKV : O_PRWKV) + ((size_t)(q.b * 16 + h) * 64 + 2 * rp) * 64 + j8 * 8);
  if (last_) {
    dst[0] = (f32x4){S0[0].x, S0[0].y, S0[1].x, S0[1].y}; dst[1] = (f32x4){S0[2].x, S0[2].y, S0[3].x, S0[3].y};
    dst[16] = (f32x4){S1[0].x, S1[0].y, S1[1].x, S1[1].y}; dst[17] = (f32x4){S1[2].x, S1[2].y, S1[3].x, S1[3].y};
  }
  }

}

__device__ void scan0_phase(KP p, char* smem) {
  const int NL = 384, NS = 2048 + 4096;
  const int G = (int)gridDim.x, b = (int)blockIdx.x;
  int next_long, long_stride;
  if (G >= 512) { next_long = b < 256 ? b : ((b >= 384 && b < 512) ? b - 128 : NL); long_stride = 1 << 20; }
  else { next_long = b; long_stride = G; }
  int cur = 0, batch_end = 0;
  for (;;) {
    int t;
    if (next_long < NL) { t = next_long; next_long += long_stride; }
    else {
      if (cur >= batch_end) {
        const int base = next_task(p->ctr + 0, smem, 8);
        if (base >= NS) break;
        cur = base; batch_end = min(base + 8, NS);
      }
      t = NL + cur++;
    }
    int is_rwkv, sq, hh, cg_ = 0;
    if (t < 128) { is_rwkv = 1; sq = t >> 4; hh = t & 15; }
    else if (t < 384) { t -= 128; is_rwkv = 0; sq = t >> 5; hh = (t >> 3) & 3; cg_ = t & 7; }
    else if (t < 384 + 2048) { t -= 384; is_rwkv = 1; sq = 8 + (t >> 4); hh = t & 15; }
    else { t -= 384 + 2048; is_rwkv = 0; sq = 8 + (t >> 5); hh = (t >> 3) & 3; cg_ = t & 7; }
    if (is_rwkv) rwkv_task(p, sq, hh, smem); else gla_task(p, sq, hh, cg_, smem);
  }
}

__device__ void gla_norm_phase(KP p) {
  const int lane = threadIdx.x & 63, wid = threadIdx.x >> 6;
  const int nw = gridDim.x * 4;
  bf16_t* PROJ = p->PROJ;
  const float4 g4 = *(const float4*)(p->in[I_GLA_GN] + lane * 4);
  for (int it0 = blockIdx.x * 4 + wid; it0 < MROWS * 4; it0 += 4 * nw) {
    uint2 uo[4], ug[4];
#pragma unroll
    for (int k = 0; k < 4; ++k) {
      const int it = it0 + k * nw;
      uo[k] = make_uint2(0, 0); ug[k] = make_uint2(0, 0);
      if (it < MROWS * 4) {
        const size_t row = it >> 2; const int h = it & 3;
        uo[k] = *(const uint2*)(PROJ + row * LD0 + C_V + h * 256 + lane * 4);
        ug[k] = *(const uint2*)(PROJ + row * LD0 + C_OG + h * 256 + lane * 4);
      }
    }
#pragma unroll
    for (int k = 0; k < 4; ++k) {
      const int it = it0 + k * nw;
      if (it < MROWS * 4) {
        const size_t row = it >> 2; const int h = it & 3;
        const float o0 = lo16(uo[k].x), o1 = hi16(uo[k].x), o2 = lo16(uo[k].y), o3 = hi16(uo[k].y);
        const float ss = wave_sum3(o0 * o0 + o1 * o1 + o2 * o2 + o3 * o3);
        const float rs = rsqrtf(ss * (1.f / 256.f) + 1e-5f);
        uint2 r;
        r.x = pack2(o0 * rs * g4.x * siluf_(lo16(ug[k].x)), o1 * rs * g4.y * siluf_(hi16(ug[k].x)));
        r.y = pack2(o2 * rs * g4.z * siluf_(lo16(ug[k].y)), o3 * rs * g4.w * siluf_(hi16(ug[k].y)));
        *(uint2*)(PROJ + row * LD0 + C_V + h * 256 + lane * 4) = r;
      }
    }
  }
}

__device__ void prep1_phase(KP p) {
  const int tid = threadIdx.x;
  const int G = (int)gridDim.x;
  for (int row = blockIdx.x; row < MROWS; row += G) {
    int t, b, sample;
    if (row < RP) { t = row & 2047; b = row >> 11; sample = 0; } else { const int rr = row - RP; b = rr >> 3; t = rr & 7; sample = 1; }
    const bf16_t* pr = p->PROJ + (size_t)row * LD1;
    for (int c = tid; c < 2560; c += 256) {
      const bool lru = c < 1024;
      const int ch = lru ? c : c - 1024;
      const int colx = lru ? D_XBR + ch : D_XBC + ch;
      const int nch = lru ? 1024 : 1536;
      const float* cw = lru ? p->in[I_LCW] : p->in[I_SCW];
      const float* stc = lru ? p->in[I_SLRUC] : p->in[I_SSSDC];
      float acc = (lru ? p->in[I_LCB] : p->in[I_SCB])[ch];
#pragma unroll
      for (int m = 0; m < 4; ++m) {
        float u = 0.f;
        if (t - m >= 0) u = bf2f(pr[colx - m * LD1]);
        else if (sample) u = stc[((size_t)b * 3 + (3 + t - m)) * nch + ch];
        acc += u * cw[(3 - m) * nch + ch];
      }
      if (lru) p->XC[(size_t)row * 1024 + ch] = f2bf(acc);
      else p->XBC[(size_t)row * 1536 + ch] = f2bf(siluf_(acc));
    }
    if (tid < 16) p->DT[(size_t)row * 16 + tid] = softplusf_(bf2f(pr[D_DT + tid]) + p->in[I_DTB][tid]);
  }
  for (int s = blockIdx.x; s < NSEQ; s += G) {
    const Seq q = get_seq(s);
    for (int e = tid; e < 3 * 2560; e += 256) {
      const int j = e / 2560, c = e - j * 2560;
      const size_t row = (size_t)(q.row0 + q.T - 3 + j);
      if (c < 1024) {
        float* o = p->out + (q.sample ? O_SLRUC : O_PLRUC) + ((size_t)q.b * 3 + j) * 1024 + c;
        *o = bf2f(p->PROJ[row * LD1 + D_XBR + c]);
      } else {
        const int ch = c - 1024;
        float* o = p->out + (q.sample ? O_SSSDC : O_PSSDC) + ((size_t)q.b * 3 + j) * 1536 + ch;
        *o = bf2f(p->PROJ[row * LD1 + D_XBC + ch]);
      }
    }
  }
}

__device__ __forceinline__ float fast_tanh(float u) { return 1.f - 2.f / (__expf(2.f * u) + 1.f); }
static __device__ __forceinline__ void lru_task(KP p, int s, int cq) {
  const Seq q = get_seq(s);
  const int ch = cq * 256 + threadIdx.x;
  bf16_t* PROJ = p->PROJ; const bf16_t* GX = p->GX;
  const int nrep_ = q.T > 8 ? ((REP_SEL < 0 || REP_SEL == 2) ? p->rep_long : 1) : p->rep_short;
  for (int rep_ = 0; rep_ < nrep_; ++rep_) {
  const bool last_ = rep_ == nrep_ - 1;
  float h = q.sample ? p->in[I_SLRU][(size_t)q.b * 1024 + ch] : 0.f;
  unsigned nla[8], ngx[8], ngt[8];
#define LRU_PREFETCH(T0)                                                          \
  _Pragma("unroll") for (int u = 0; u < 8; ++u) {                                 \
    const size_t row_ = (size_t)(q.row0 + (T0) + u);                              \
    nla[u] = PROJ[row_ * LD1 + D_XBR + ch]; ngx[u] = GX[row_ * 1024 + ch]; ngt[u] = PROJ[row_ * LD1 + D_GATE + ch]; \
  }
  LRU_PREFETCH(0);
  for (int t0 = 0; t0 < q.T; t0 += 8) {
    float a[8], bt[8], ge[8];
#pragma unroll
    for (int u = 0; u < 8; ++u) {
      const float la = bf2f(nla[u]), gx = bf2f(ngx[u]), gt = bf2f(ngt[u]);
      a[u] = __expf(la);
      const float x = 2.f * la;
      const float om = (x > -0.1f) ? -x * (1.f + x * (0.5f + x * (0.16666667f + x * 0.041666668f))) : 1.f - __expf(x);
      bt[u] = __builtin_amdgcn_sqrtf(fmaxf(om, 0.f)) * gx;
      const float uu = 0.7978845608028654f * (gt + 0.044715f * gt * gt * gt);
      ge[u] = 0.5f * gt * (1.f + fast_tanh(uu));
    }
    if (t0 + 8 < q.T) LRU_PREFETCH(t0 + 8);
#pragma unroll
    for (int u = 0; u < 8; ++u) {
      const size_t row = (size_t)(q.row0 + t0 + u);
      h = fmaf(a[u], h, bt[u]);
      if (last_) PROJ[row * LD1 + D_GATE + ch] = f2bf(h * ge[u]);
    }
  }
#undef LRU_PREFETCH
  if (last_) p->out[(q.sample ? O_SLRU : O_PLRU) + (size_t)q.b * 1024 + ch] = h;
  }

}

static __device__ __forceinline__ void ssd_task(KP p, int s, int h, int pg, char* smem) {
  float* sB = (float*)smem; float* sC = sB + 4096; float* sx = sC + 4096; float* so = sx + 1024; float* sda = so + 1024; float* sdt = sda + 32;
  const Seq q = get_seq(s);
  const int tid = threadIdx.x, c = tid >> 3, ng = tid & 7;
  const int stt = tid >> 4, skc = tid & 15;
  const int g = h >> 3;
  bf16_t* PROJ = p->PROJ; const bf16_t* XBC = p->XBC; const float* DT = p->DT;
  f32x2 S[8];
  if (q.sample) {
    const f32x4* st = (const f32x4*)(p->in[I_SSSD] + ((size_t)(q.b * 16 + h) * 64 + pg * 32 + c) * 128 + ng * 16);
#pragma unroll
    for (int u = 0; u < 4; ++u) { f32x4 v = st[u]; S[2 * u] = v.xy; S[2 * u + 1] = v.zw; }
  } else {
#pragma unroll
    for (int u = 0; u < 8; ++u) S[u] = (f32x2){0.f, 0.f};
  }
  const float Ah = -__expf(p->in[I_ALOG][h]);
  const float Dh = p->in[I_SD][h];
  uint4 ub0 = make_uint4(0, 0, 0, 0), uc0 = ub0, ub1 = ub0, uc1 = ub0; unsigned ux0 = 0, uz0 = 0, ux1 = 0, uz1 = 0; float udt0 = 0.f, udt1 = 0.f;
#define SSD_PF1(T0, R, UB, UC, UX, UZ, UDT)                                                \
    if ((R) < ns_) {                                                                       \
      const size_t row_ = (size_t)(q.row0 + (T0) + (R));                                   \
      const bf16_t* px_ = XBC + row_ * 1536;                                               \
      UB = *(const uint4*)(px_ + 1024 + g * 128 + skc * 8);                                \
      UC = *(const uint4*)(px_ + 1280 + g * 128 + skc * 8);                                \
      UX = *(const unsigned*)(px_ + h * 64 + pg * 32 + skc * 2);                           \
      UZ = *(const unsigned*)(PROJ + row_ * LD1 + D_Z + h * 64 + pg * 32 + skc * 2);       \
      UDT = DT[row_ * 16 + h];                                                             \
    }
#define SSD_PREFETCH(T0)                                                                   \
  { const int ns_ = min(32, q.T - (T0));                                                   \
    SSD_PF1(T0, stt, ub0, uc0, ux0, uz0, udt0) SSD_PF1(T0, stt + 16, ub1, uc1, ux1, uz1, udt1) }
#define SSD_ST1(R, UB, UC, UX, UDT)                                                        \
    if ((R) < ns) {                                                                        \
      f32x4* db = (f32x4*)(sB + (R) * 128 + skc * 8); f32x4* dc = (f32x4*)(sC + (R) * 128 + skc * 8); \
      db[0] = (f32x4){lo16(UB.x), hi16(UB.x), lo16(UB.y), hi16(UB.y)};                     \
      db[1] = (f32x4){lo16(UB.z), hi16(UB.z), lo16(UB.w), hi16(UB.w)};                     \
      dc[0] = (f32x4){lo16(UC.x), hi16(UC.x), lo16(UC.y), hi16(UC.y)};                     \
      dc[1] = (f32x4){lo16(UC.z), hi16(UC.z), lo16(UC.w), hi16(UC.w)};                     \
      *(f32x2*)(sx + (R) * 32 + skc * 2) = (f32x2){lo16(UX), hi16(UX)};                    \
      if (skc == 0) { sdt[(R)] = UDT; sda[(R)] = __expf(UDT * Ah); }                       \
    }
  SSD_PREFETCH(0);
  for (int t0 = 0; t0 < q.T; t0 += 32) {
    const int ns = min(32, q.T - t0);
    __syncthreads();
    const unsigned zc0 = uz0, zc1 = uz1;
    SSD_ST1(stt, ub0, uc0, ux0, udt0)
    SSD_ST1(stt + 16, ub1, uc1, ux1, udt1)
    __syncthreads();
    if (t0 + 32 < q.T) SSD_PREFETCH(t0 + 32);
    struct SsdOps { float xv, da, dt; f32x4 b[4], c[4]; };
    auto ssd_load = [&](const int tt, SsdOps& o) {
      o.xv = sx[tt * 32 + c]; o.da = sda[tt]; o.dt = sdt[tt];
      const f32x4* b4 = (const f32x4*)(sB + tt * 128 + ng * 16);
      const f32x4* c4 = (const f32x4*)(sC + tt * 128 + ng * 16);
#pragma unroll
      for (int u = 0; u < 4; ++u) { o.b[u] = b4[u]; o.c[u] = c4[u]; }
    };
    auto ssd_math = [&](const SsdOps& o) -> float {
      const float dx = o.dt * o.xv;
      const f32x2 da2 = (f32x2){o.da, o.da}, dx2 = (f32x2){dx, dx};
      f32x2 ya = (f32x2){0.f, 0.f}, yb = (f32x2){0.f, 0.f};
#pragma unroll
      for (int u = 0; u < 4; ++u) {
        S[2 * u] = da2 * S[2 * u] + dx2 * o.b[u].xy;         ya = o.c[u].xy * S[2 * u] + ya;
        S[2 * u + 1] = da2 * S[2 * u + 1] + dx2 * o.b[u].zw; yb = o.c[u].zw * S[2 * u + 1] + yb;
      }
      ya += yb;
      return ya.x + ya.y + (ng == 0 ? Dh * o.xv : 0.f);
    };
    if (ns == 32) {
      SsdOps oa, ob;
      ssd_load(0, oa);
#pragma unroll
      for (int hh = 0; hh < 2; ++hh) {
        float yv[16];
#pragma unroll
        for (int tt = 0; tt < 16; tt += 4) {
#pragma unroll
          for (int u = 0; u < 4; u += 2) {
            ssd_load(hh * 16 + tt + u + 1, ob);
            __builtin_amdgcn_sched_barrier(0);
            yv[tt + u] = ssd_math(oa);
            __builtin_amdgcn_sched_barrier(0);
            ssd_load(min(hh * 16 + tt + u + 2, 31), oa);
            __builtin_amdgcn_sched_barrier(0);
            yv[tt + u + 1] = ssd_math(ob);
            __builtin_amdgcn_sched_barrier(0);
          }
#pragma unroll
          for (int u = 0; u < 4; ++u) yv[tt + u] = sum8(yv[tt + u]);
          __builtin_amdgcn_sched_barrier(0);
        }
        if (ng == 0) {
#pragma unroll
          for (int tt = 0; tt < 16; ++tt) so[(hh * 16 + tt) * 32 + c] = yv[tt];
        }
      }
    } else {
      for (int tt = 0; tt < ns; ++tt) { SsdOps o; ssd_load(tt, o); const float y = sum8(ssd_math(o)); if (ng == 0) so[tt * 32 + c] = y; }
    }
    __syncthreads();
    if (stt < ns) {
      const size_t row = (size_t)(q.row0 + t0 + stt);
      *(unsigned*)(PROJ + row * LD1 + D_Z + h * 64 + pg * 32 + skc * 2) =
          pack2(so[stt * 32 + skc * 2] * siluf_(lo16(zc0)), so[stt * 32 + skc * 2 + 1] * siluf_(hi16(zc0)));
    }
    if (stt + 16 < ns) {
      const size_t row = (size_t)(q.row0 + t0 + stt + 16);
      *(unsigned*)(PROJ + row * LD1 + D_Z + h * 64 + pg * 32 + skc * 2) =
          pack2(so[(stt + 16) * 32 + skc * 2] * siluf_(lo16(zc1)), so[(stt + 16) * 32 + skc * 2 + 1] * siluf_(hi16(zc1)));
    }
  }
#undef SSD_PREFETCH
#undef SSD_PF1
#undef SSD_ST1
  f32x4* dst = (f32x4*)(p->out + (q.sample ? O_SSSD : O_PSSD) + ((size_t)(q.b * 16 + h) * 64 + pg * 32 + c) * 128 + ng * 16);
#pragma unroll
  for (int u = 0; u < 4; ++u) dst[u] = (f32x4){S[2 * u].x, S[2 * u].y, S[2 * u + 1].x, S[2 * u + 1].y};
}

__device__ void scan1_phase(KP p, char* smem) {
  const int NL = 288, NS = 4096 + 512;
  const int G = (int)gridDim.x, b = (int)blockIdx.x;
  int next_long = b;
  int cur = 0, batch_end = 0;
  for (;;) {
    int t;
    if (next_long < NL) { t = next_long; next_long += G; }
    else {
      if (cur >= batch_end) {
        const int base = next_task(p->ctr + 1, smem, 8);
        if (base >= NS) break;
        cur = base; batch_end = min(base + 8, NS);
      }
      t = NL + cur++;
    }
    int is_lru, sq, a1, a2 = 0;
    if (t < 32) { is_lru = 1; sq = t >> 2; a1 = t & 3; }
    else if (t < 288) { t -= 32; is_lru = 0; sq = t >> 5; a1 = (t >> 1) & 15; a2 = t & 1; }
    else if (t < 288 + 4096) { t -= 288; is_lru = 0; sq = 8 + (t >> 5); a1 = (t >> 1) & 15; a2 = t & 1; }
    else { t -= 288 + 4096; is_lru = 1; sq = 8 + (t >> 2); a1 = t & 3; }
    if (is_lru) lru_task(p, sq, a1); else ssd_task(p, sq, a1, a2, smem);
  }
}

__device__ void ssd_norm_phase(KP p) {
  const int lane = threadIdx.x & 63, wid = threadIdx.x >> 6;
  const int nw = gridDim.x * 4;
  bf16_t* PROJ = p->PROJ;
  const float* nwt = p->in[I_SNW];
  const float4 wa0 = *(const float4*)(nwt + lane * 8), wa1 = *(const float4*)(nwt + lane * 8 + 4);
  const float4 wb0 = *(const float4*)(nwt + 512 + lane * 8), wb1 = *(const float4*)(nwt + 512 + lane * 8 + 4);
  for (int it0 = blockIdx.x * 4 + wid; it0 < MROWS * 2; it0 += 4 * nw) {
    uint4 uu[4];
#pragma unroll
    for (int k = 0; k < 4; ++k) {
      const int it = it0 + k * nw;
      uu[k] = make_uint4(0, 0, 0, 0);
      if (it < MROWS * 2) { const size_t row = it >> 1; const int g = it & 1; uu[k] = *(const uint4*)(PROJ + row * LD1 + D_Z + g * 512 + lane * 8); }
    }
#pragma unroll
    for (int k = 0; k < 4; ++k) {
      const int it = it0 + k * nw;
      if (it < MROWS * 2) {
        const size_t row = it >> 1; const int g = it & 1;
        const uint4 u = uu[k];
        const float v[8] = {lo16(u.x), hi16(u.x), lo16(u.y), hi16(u.y), lo16(u.z), hi16(u.z), lo16(u.w), hi16(u.w)};
        float ss = 0.f;
#pragma unroll
        for (int j = 0; j < 8; ++j) ss += v[j] * v[j];
        ss = wave_sum3(ss);
        const float rs = rsqrtf(ss * (1.f / 512.f) + 1e-5f);
        const float4 w0 = g ? wb0 : wa0, w1 = g ? wb1 : wa1;
        uint4 r;
        r.x = pack2(v[0] * rs * w0.x, v[1] * rs * w0.y); r.y = pack2(v[2] * rs * w0.z, v[3] * rs * w0.w);
        r.z = pack2(v[4] * rs * w1.x, v[5] * rs * w1.y); r.w = pack2(v[6] * rs * w1.z, v[7] * rs * w1.w);
        *(uint4*)(PROJ + row * LD1 + D_Z + g * 512 + lane * 8) = r;
      }
    }
  }
}

#define XB_TMO      128
#define XB_XCNT(j)  (256  + 64 * (j))
#define XB_XSUB(j)  (1280 + 64 * (j))
#define XB_XGEN(j)  (2304 + 64 * (j))
#define XB_TOP      3328
#define XB_TOPGEN   3392
#define XCD_BAR_WORDS 3456
#define XB_SPIN_CAP (1u << 18)
__device__ __forceinline__ unsigned xb_ld(unsigned* p)              { return __hip_atomic_load(p, __ATOMIC_RELAXED, __HIP_MEMORY_SCOPE_AGENT); }
__device__ __forceinline__ unsigned xb_add(unsigned* p, unsigned v) { return __hip_atomic_fetch_add(p, v, __ATOMIC_RELAXED, __HIP_MEMORY_SCOPE_AGENT); }
__device__ __forceinline__ unsigned xb_xcc_id() { return (unsigned)__builtin_amdgcn_s_getreg((3 << 11) | 20) & 0xFu; }
#define XB_SPIN(cond, bar) do { unsigned _sp = 0; while (cond) { __builtin_amdgcn_s_sleep(1); \
    if ((++_sp & 255u) == 0u) { if (xb_ld(&(bar)[XB_TMO])) break; if (_sp > XB_SPIN_CAP) { atomicAdd(&(bar)[XB_TMO], 1u); break; } } } } while (0)

__device__ __forceinline__ void xcd_barrier(unsigned* bar, unsigned x, unsigned nloc, unsigned nx) {
  asm volatile("s_waitcnt vmcnt(0)" ::: "memory");
  __syncthreads();
  if (threadIdx.x == 0) {
    __builtin_amdgcn_s_waitcnt(0);
    const unsigned old = xb_add(&bar[XB_XSUB(x)], 1u);
    const unsigned gen = old / nloc;
    if (old + 1u == (gen + 1u) * nloc) {
      __builtin_amdgcn_fence(__ATOMIC_RELEASE, "agent");
      asm volatile("s_waitcnt vmcnt(0)" ::: "memory");
      const unsigned og = xb_add(&bar[XB_TOP], 1u);
      const unsigned tg = og / nx;
      if (og + 1u == (tg + 1u) * nx) xb_add(&bar[XB_TOPGEN], 1u);
      else XB_SPIN(xb_ld(&bar[XB_TOPGEN]) == tg, bar);
      __builtin_amdgcn_fence(__ATOMIC_ACQUIRE, "agent");
      xb_add(&bar[XB_XGEN(x)], 1u);
      asm volatile("s_waitcnt vmcnt(0)" ::: "memory");
    } else {
      XB_SPIN(xb_ld(&bar[XB_XGEN(x)]) == gen, bar);
      __builtin_amdgcn_fence(__ATOMIC_ACQUIRE, "agent");
      asm volatile("s_waitcnt vmcnt(0)" ::: "memory");
    }
  }
  __syncthreads();
}

constexpr int N_PHASES = 21;
#ifndef PH_MASK
#define PH_MASK 0xffffffffu
#endif
#define PH_ON(k) (((PH_MASK) >> (k)) & 1u)

template <int PH>
__device__ __forceinline__ void run_phase(KP p, char* smem, const Sched sc) {
  float* X = p->out;
  switch (PH) {
    case 0: if (PH_ON(0)) {
      if (blockIdx.x == 0 && threadIdx.x == 0) { p->ctr[0] = 0u; p->ctr[1] = 0u; p->ctr[2] = 0u; p->ctr[3] = 0u; }
      int rot = 0;
      conv_wt(p->in[I_WIN0], nullptr, LD0, 1024, LD0, p->Win0t, 0, smem, rot);
      conv_wt(p->in[I_WOUT0], nullptr, 1024, 2048, 1024, p->Wout0t, 0, smem, rot);
      conv_wt(p->in[I_WIN1], nullptr, LD1, 1024, LD1, p->Win1t, 0, smem, rot);
      conv_wt(p->in[I_WOUT1], nullptr, 1024, 2048, 1024, p->Wout1t, 0, smem, rot);
      conv_wt(p->in[I_WG], p->in[I_WU], DFF, 1024, 2 * DFF, p->Wgu0, 1, smem, rot);
      conv_wt(p->in[I_WG] + (size_t)1024 * DFF, p->in[I_WU] + (size_t)1024 * DFF, DFF, 1024, 2 * DFF, p->Wgu1, 1, smem, rot);
      conv_wt(p->in[I_WD], nullptr, 1024, DFF, 1024, p->Wdn0, 0, smem, rot);
      conv_wt(p->in[I_WD] + (size_t)DFF * 1024, nullptr, 1024, DFF, 1024, p->Wdn1, 0, smem, rot);
      conv_wt(p->in[I_W2], nullptr, 1024, 64, 1024, p->w2t, 0, smem, rot);
      conv_wt(p->in[I_A2], nullptr, 1024, 64, 1024, p->a2t, 0, smem, rot);
      conv_wt(p->in[I_G2], nullptr, 1024, 128, 1024, p->g2t, 0, smem, rot);
#pragma unroll 1
      for (int blk = 0; blk < 8; ++blk)
        conv_wt(p->in[I_LWR] + blk * 16384, p->in[I_LWI] + blk * 16384, 128, 128, 256, p->Wri + blk * 32768, 1, smem, rot);
      rmsnorm_phase(p->in[I_XP], p->in[I_XS], p->in[I_GMIX], p->H);
    } break;
    case 1: if (PH_ON(1)) {
      GemmArgs g{p->H, p->H, p->Win0t, 1024, 1024, 1 << 30, MROWS, LD0, 1024};
      gemm_run_big<3>(g, EpiBf16{p->PROJ, LD0, LD0}, smem, sc);
    } break;
    case 2: if (PH_ON(2)) prep0_phase(p); break;
    case 3: if (PH_ON(3)) {
      GemmArgs g0{p->L, p->L, p->w2t, 256, 256, 1 << 30, MROWS, 1024, 64};
      gemm_run(g0, EpiLora<0>{p->EW, p->in[I_W0]}, smem, sc);
      GemmArgs g1{p->L + 64, p->L + 64, p->a2t, 256, 256, 1 << 30, MROWS, 1024, 64};
      gemm_run(g1, EpiLora<1>{p->AA, p->in[I_A0]}, smem, sc, 8);
      GemmArgs g2{p->L + 128, p->L + 128, p->g2t, 256, 256, 1 << 30, MROWS, 1024, 128};
      gemm_run(g2, EpiLora<2>{p->GG, nullptr}, smem, sc, 16);
    } break;
    case 4: if (PH_ON(4)) {
      scan0_phase(p, smem); } break;
    case 5: if (PH_ON(5)) gla_norm_phase(p); break;
    case 6: if (PH_ON(6)) {
      GemmArgs g{p->PROJ + C_V, p->PROJ + C_R, p->Wout0t, LD0, LD0, 1024, MROWS, 1024, 2048};
      gemm_run_272(g, p->in[I_XP], p->in[I_XS], X, smem, sc);
    } break;
    case 7: if (PH_ON(7)) rmsnorm_phase(X, X + (size_t)RP * 1024, p->in[I_GFFN], p->H); break;
    case 8: if (PH_ON(8)) {
      GemmArgs g{p->H, p->H, p->Wgu0, 1024, 1024, 1 << 30, MROWS, 2 * DFF, 1024};
#ifdef GVAR
      gemm_run_big<GVAR>(g, EpiGateUp{p->PROJ}, smem, sc);
#endif
      gemm_run_big<3>(g, EpiGateUp{p->PROJ}, smem, sc);
    } break;
    case 9: if (PH_ON(9)) {
      GemmArgs g{p->PROJ, p->PROJ, p->Wdn0, DFF, DFF, 1 << 30, MROWS, 1024, DFF};
      gemm_run_272(g, X, X + (size_t)RP * 1024, X, smem, sc);
    } break;
    case 10: if (PH_ON(10)) rmsnorm_phase(X, X + (size_t)RP * 1024, p->in[I_GMIX] + 1024, p->H); break;
    case 11: if (PH_ON(11)) {
      GemmArgs g{p->H, p->H, p->Win1t, 1024, 1024, 1 << 30, MROWS, LD1, 1024};
      gemm_run_big<3>(g, EpiBf16{p->PROJ, LD1, LD1}, smem, sc);
    } break;
    case 12: if (PH_ON(12)) prep1_phase(p); break;
    case 13: if (PH_ON(13)) {
#pragma unroll 1
      for (int blk = 0; blk < 8; ++blk) {
        GemmArgs g{p->XC + blk * 128, p->XC + blk * 128, p->Wri + blk * 32768, 1024, 1024, 1 << 30, MROWS, 256, 128};
        gemm_run(g, EpiLruGate{p->PROJ, p->GX, p->XC, p->in[I_LBR], p->in[I_LBI], p->in[I_LAMBDA], blk}, smem, sc, blk * 34);
      }
    } break;
    case 14: if (PH_ON(14)) {
      scan1_phase(p, smem); } break;
    case 15: if (PH_ON(15)) ssd_norm_phase(p); break;
    case 16: if (PH_ON(16)) {
      GemmArgs g{p->PROJ + D_GATE, p->PROJ + D_Z, p->Wout1t, LD1, LD1, 1024, MROWS, 1024, 2048};
      gemm_run_272(g, X, X + (size_t)RP * 1024, X, smem, sc);
    } break;
    case 17: if (PH_ON(17)) rmsnorm_phase(X, X + (size_t)RP * 1024, p->in[I_GFFN] + 1024, p->H); break;
    case 18: if (PH_ON(18)) {
      GemmArgs g{p->H, p->H, p->Wgu1, 1024, 1024, 1 << 30, MROWS, 2 * DFF, 1024};
      gemm_run_big<3>(g, EpiGateUp{p->PROJ}, smem, sc);
    } break;
    case 19: if (PH_ON(19)) {
      GemmArgs g{p->PROJ, p->PROJ, p->Wdn1, DFF, DFF, 1 << 30, MROWS, 1024, DFF};
      gemm_run_272(g, X, X + (size_t)RP * 1024, X, smem, sc);
    } break;
    case 20: if (PH_ON(20)) final_norm_phase(X, p->in[I_GFINAL]); break;
    default: break;
  }
}

struct XB { unsigned* bar; unsigned x, nloc, nx, rank, xidx; };

template <int PH>
__device__ __forceinline__ void phase_step(char* smem, cg::grid_group& grid, XB& xb) {
  KP p = (KP)__builtin_amdgcn_kernarg_segment_ptr();
  asm volatile("" : "+s"(p));
  {
    Sched sc; sc.xidx = (int)xb.xidx; sc.nx = (int)xb.nx; sc.rank = (int)xb.rank; sc.nloc = (int)xb.nloc;
    run_phase<PH>(p, smem, sc);
  }
  if (PH == 0) {
    grid.sync();
    unsigned nloc = 1u, nx = 0u, xi = 0u;
#pragma unroll
    for (unsigned j = 0; j < 16; ++j) {
      const unsigned c = xb_ld(&xb.bar[XB_XCNT(j)]);
      nx += (c > 0u) ? 1u : 0u;
      xi += (c > 0u && j < xb.x) ? 1u : 0u;
      nloc = (j == xb.x) ? c : nloc;
    }
    xb.xidx = (unsigned)__builtin_amdgcn_readfirstlane((int)xi);
    xb.nloc = (unsigned)__builtin_amdgcn_readfirstlane((int)(nloc > 0u ? nloc : 1u));
    xb.nx = (unsigned)__builtin_amdgcn_readfirstlane((int)(nx > 0u ? nx : 1u));
  } else if (PH + 1 < N_PHASES) {
    xcd_barrier(xb.bar, xb.x, xb.nloc, xb.nx);
#ifdef EXTRA_SYNC
    xcd_barrier(xb.bar, xb.x, xb.nloc, xb.nx); xcd_barrier(xb.bar, xb.x, xb.nloc, xb.nx);
#endif
  }
}

__global__ void __launch_bounds__(256, 2) mk_forward(Params pdummy) {
  __shared__ __attribute__((aligned(16))) char smem[65536];
  cg::grid_group grid = cg::this_grid();
  XB xb;
  {
    KP p = (KP)__builtin_amdgcn_kernarg_segment_ptr();
    xb.bar = p->bar; xb.x = xb_xcc_id(); xb.nloc = 1u; xb.nx = 1u; xb.xidx = 0u;
    unsigned rk = 0u;
    if (threadIdx.x == 0) rk = xb_add(&xb.bar[XB_XCNT(xb.x)], 1u);
    xb.rank = (unsigned)__builtin_amdgcn_readfirstlane((int)rk);
    {
      unsigned* sh = (unsigned*)(smem + 65028);
      if (threadIdx.x == 0) *sh = rk;
      __syncthreads();
      xb.rank = (unsigned)__builtin_amdgcn_readfirstlane((int)*sh);
      __syncthreads();
    }
  }
  phase_step<0>(smem, grid, xb);   phase_step<1>(smem, grid, xb);   phase_step<2>(smem, grid, xb);
  phase_step<3>(smem, grid, xb);   phase_step<4>(smem, grid, xb);   phase_step<5>(smem, grid, xb);
  phase_step<6>(smem, grid, xb);   phase_step<7>(smem, grid, xb);   phase_step<8>(smem, grid, xb);
  phase_step<9>(smem, grid, xb);   phase_step<10>(smem, grid, xb);  phase_step<11>(smem, grid, xb);
  phase_step<12>(smem, grid, xb);  phase_step<13>(smem, grid, xb);  phase_step<14>(smem, grid, xb);
  phase_step<15>(smem, grid, xb);  phase_step<16>(smem, grid, xb);  phase_step<17>(smem, grid, xb);
  phase_step<18>(smem, grid, xb);  phase_step<19>(smem, grid, xb);  phase_step<20>(smem, grid, xb);
}

#ifndef MK_SPLIT
#define MK_SPLIT 0
#endif

extern "C" void kernel_launch(void* const* d_in, const int* in_sizes, int n_in, void* d_out, int out_size, void* d_ws,
                              size_t ws_size, hipStream_t stream) {
  static int grid_blocks = 0;
  if (!grid_blocks) {
    int dev = 0, cus = 0, per_cu = 0;
    hipGetDevice(&dev);
    hipDeviceGetAttribute(&cus, hipDeviceAttributeMultiprocessorCount, dev);
    hipOccupancyMaxActiveBlocksPerMultiprocessor(&per_cu, mk_forward, 256, 0);
    if (per_cu > 2) per_cu = 2;
    grid_blocks = cus * per_cu;
  }
  Params p{};
  for (int i = 0; i < N_IN; ++i) p.in[i] = (const float*)d_in[i];
  p.out = (float*)d_out;
  char* w = (char*)d_ws;
  size_t off = 0;
  auto take = [&](size_t bytes) { char* r = w + off; off += (bytes + 255) & ~(size_t)255; return r; };
  p.ctr = (unsigned*)take(256);
  p.bar = (unsigned*)take(XCD_BAR_WORDS * 4);
  p.Win0t = (bf16_t*)take((size_t)LD0 * 1024 * 2);
  p.Wout0t = (bf16_t*)take((size_t)1024 * 2048 * 2);
  p.Win1t = (bf16_t*)take((size_t)LD1 * 1024 * 2);
  p.Wout1t = (bf16_t*)take((size_t)1024 * 2048 * 2);
  p.Wgu0 = (bf16_t*)take((size_t)2 * DFF * 1024 * 2);
  p.Wgu1 = (bf16_t*)take((size_t)2 * DFF * 1024 * 2);
  p.Wdn0 = (bf16_t*)take((size_t)1024 * DFF * 2);
  p.Wdn1 = (bf16_t*)take((size_t)1024 * DFF * 2);
  p.w2t = (bf16_t*)take((size_t)1024 * 64 * 2);
  p.a2t = (bf16_t*)take((size_t)1024 * 64 * 2);
  p.g2t = (bf16_t*)take((size_t)1024 * 128 * 2);
  p.Wri = (bf16_t*)take((size_t)8 * 256 * 128 * 2);
  p.PROJ = (bf16_t*)take((size_t)MROWS * LD0 * 2);
  p.H = (bf16_t*)take((size_t)MROWS * 1024 * 2);
  p.GG = p.H;
  p.XC = p.H;
  const size_t off_extra = off;
  p.L = (bf16_t*)take((size_t)MROWS * 256 * 2);
  p.LA = (bf16_t*)take((size_t)MROWS * 512 * 2);
  size_t end0 = off;
  off = off_extra;
  p.GX = (bf16_t*)take((size_t)MROWS * 1024 * 2);
  p.DT = (float*)take((size_t)MROWS * 16 * 4);
  size_t end1 = off;
  p.XBC = p.PROJ + (size_t)MROWS * LD1 + 128;
  p.EW = (bf16_t*)((float*)d_out + O_SLRU);
  p.AA = p.EW + (size_t)MROWS * 1024;
  size_t need = end0 > end1 ? end0 : end1;
  if (need > ws_size || (size_t)out_size < O_END) {
    fprintf(stderr, "workspace too small: need %zu have %zu (out %d)\n", need, ws_size, out_size);
    return;
  }
  hipMemsetAsync(p.bar, 0, XCD_BAR_WORDS * 4, stream);
  p.ph_begin = 0; p.ph_end = N_PHASES;
#ifndef REP_LONG
#define REP_LONG 1
#endif
#ifndef REP_SHORT
#define REP_SHORT 1
#endif
  p.rep_long = REP_LONG; p.rep_short = REP_SHORT;
  void* args[] = {&p};
  hipError_t e = hipLaunchCooperativeKernel((void*)mk_forward, dim3(grid_blocks), dim3(256), args, 0, stream);
  if (e != hipSuccess) fprintf(stderr, "cooperative launch failed: %s (grid %d)\n", hipGetErrorString(e), grid_blocks);
}
```
